# Optimizing an MI355X kernel written in HIP

```python
import jax, jax.numpy as jnp
from jax import lax
import numpy as np

D_MODEL = 1024
BATCH = 2
SEQ = 8192
DEPTH = 2

GRID_W = 64
HEAD_DIM = 64
NA_HEADS = 4
NA_ROWS_MAX = 8
NA_COLS = 16
SWA_Q_HEADS = 8
SWA_KV_HEADS = 2
SWA_WINDOW = 128
SWA_BLOCK = 128
POOL_WINDOWS = (2, 4, 8, 16)
POOL_GROUP_DIM = 64
D_A = NA_HEADS * HEAD_DIM
D_B = SWA_Q_HEADS * HEAD_DIM
D_BKV = SWA_KV_HEADS * HEAD_DIM
D_C = len(POOL_WINDOWS) * POOL_GROUP_DIM
D_MIX = D_A + D_B + D_C
D_IN = 3 * D_A + D_B + 2 * D_BKV + D_C
N_GROUPS = 4
EXPERTS_PER_GROUP = 8
N_EXPERTS = N_GROUPS * EXPERTS_PER_GROUP
TOP_K_INNER = 2
D_EXPERT = 256
RMS_EPS = 1e-6

kernel_name = 'hybrid_natten_swa_pool_hmoe_encoder'


def rmsnorm(x, g):
    xf = x.astype(jnp.float32)
    y = xf * lax.rsqrt(jnp.mean(xf * xf, axis=-1, keepdims=True) + RMS_EPS)
    return (y * g.astype(jnp.float32)).astype(x.dtype)


def alibi_slopes(n):
    return (2.0 ** (-8.0 * np.arange(1, n + 1) / n)).astype(np.float32)


def neighbourhood_attention(q, k, v, rel_bias):
    B, S, H, Dh = q.shape
    rows = S // GRID_W
    kr = min(NA_ROWS_MAX, rows)

    def to_grid(a):
        return a.reshape(B, rows, GRID_W, H, Dh).transpose(0, 3, 1, 2, 4)

    qg, kg, vg = to_grid(q * (Dh ** -0.5)), to_grid(k), to_grid(v)
    cols = np.arange(GRID_W)
    col_start = np.clip(cols - NA_COLS // 2, 0, GRID_W - NA_COLS)
    col_idx = col_start[:, None] + np.arange(NA_COLS)[None, :]
    dc_idx = col_idx - cols[:, None] + (NA_COLS - 1)
    bias_c = rel_bias.astype(jnp.float32)[:, :, dc_idx]

    def row_step(r):
        rs = jnp.clip(r - kr // 2, 0, rows - kr)
        q_r = lax.dynamic_index_in_dim(qg, r, axis=2, keepdims=False)
        k_r = lax.dynamic_slice_in_dim(kg, rs, kr, axis=2)[:, :, :, col_idx]
        v_r = lax.dynamic_slice_in_dim(vg, rs, kr, axis=2)[:, :, :, col_idx]
        dr_idx = rs + jnp.arange(kr) - r + (NA_ROWS_MAX - 1)
        bias = jnp.take(bias_c, dr_idx, axis=1).transpose(0, 2, 1, 3)
        s = jnp.einsum('bhcd,bhrcjd->bhcrj', q_r, k_r).astype(jnp.float32) + bias
        p = jax.nn.softmax(s.reshape(B, H, GRID_W, kr * NA_COLS), axis=-1)
        p = p.reshape(s.shape).astype(v.dtype)
        return jnp.einsum('bhcrj,bhrcjd->bhcd', p, v_r)

    o = lax.map(row_step, jnp.arange(rows))
    return o.transpose(1, 0, 3, 2, 4).reshape(B, S, H * Dh)


def sliding_window_gqa(q, k, v, sink):
    B, S, Hq, Dh = q.shape
    Hkv = k.shape[2]
    rep = Hq // Hkv
    nb = S // SWA_BLOCK
    qb = (q * (Dh ** -0.5)).reshape(B, nb, SWA_BLOCK, Hkv, rep, Dh)
    pad = ((0, 0), (SWA_BLOCK, SWA_BLOCK), (0, 0), (0, 0))
    kp, vp = jnp.pad(k, pad), jnp.pad(v, pad)

    def band(a):
        return jnp.concatenate(
            [a[:, i * SWA_BLOCK: i * SWA_BLOCK + S].reshape(B, nb, SWA_BLOCK, Hkv, Dh) for i in range(3)],
            axis=2)

    kb, vb = band(kp), band(vp)
    qi = np.arange(SWA_BLOCK)
    ki = np.arange(3 * SWA_BLOCK)
    diff = ki[None, :] - qi[:, None] - SWA_BLOCK
    kpos = (np.arange(nb)[:, None] - 1) * SWA_BLOCK + ki[None, :]
    valid = (np.abs(diff) <= SWA_WINDOW)[None] & ((kpos >= 0) & (kpos < S))[:, None, :]
    slopes = jnp.asarray(alibi_slopes(Hq)).reshape(Hkv, rep)
    alibi = -slopes[:, :, None, None] * jnp.asarray(np.abs(diff).astype(np.float32))
    s = jnp.einsum('bnqgrd,bnkgd->bngrqk', qb, kb).astype(jnp.float32)
    s = jnp.where(jnp.asarray(valid)[None, :, None, None], s + alibi, -jnp.inf)
    sink_logit = jnp.broadcast_to(sink.astype(jnp.float32).reshape(Hkv, rep, 1, 1),
                                  (B, nb, Hkv, rep, SWA_BLOCK, 1))
    p = jax.nn.softmax(jnp.concatenate([s, sink_logit], axis=-1), axis=-1)[..., :-1].astype(v.dtype)
    o = jnp.einsum('bngrqk,bnkgd->bnqgrd', p, vb)
    return o.reshape(B, S, Hq * Dh)


def multiscale_pool(u, pool_w, pool_scale):
    B, S, C = u.shape
    uf = u.astype(jnp.float32)
    csum = jnp.concatenate([jnp.zeros((B, 1, C), jnp.float32), jnp.cumsum(uf, axis=1)], axis=1)
    t = np.arange(S)
    outs = []
    for gi, w in enumerate(POOL_WINDOWS):
        sl = slice(gi * POOL_GROUP_DIM, (gi + 1) * POOL_GROUP_DIM)
        lo = np.clip(t - w // 2, 0, S)
        hi = np.clip(t + w // 2, 0, S)
        c = csum[:, :, sl]
        cnt = jnp.asarray((hi - lo).astype(np.float32))[None, :, None]
        d = ((c[:, hi] - c[:, lo]) / cnt - uf[:, :, sl]).astype(u.dtype)
        outs.append(d @ pool_w[gi])
    return jnp.concatenate(outs, axis=-1) * pool_scale


def hierarchical_moe(h, rg_w, rg_b, re_w, re_b, e_gate, e_up, e_down):
    B, S, D = h.shape
    t = h.reshape(-1, D)
    g_prob = jax.nn.softmax((t @ rg_w).astype(jnp.float32) + rg_b.astype(jnp.float32), axis=-1)
    g_top_p, g_top = lax.top_k(g_prob, 1)
    e_logits = ((t @ re_w).astype(jnp.float32) + re_b.astype(jnp.float32)).reshape(-1, N_GROUPS, EXPERTS_PER_GROUP)
    e_sel = jnp.take_along_axis(e_logits, g_top[:, :, None], axis=1)[:, 0]
    e_top_p, e_top = lax.top_k(jax.nn.softmax(e_sel, axis=-1), TOP_K_INNER)
    gates = g_top_p * e_top_p / jnp.sum(e_top_p, axis=-1, keepdims=True)
    expert_id = g_top * EXPERTS_PER_GROUP + e_top
    combine = jnp.sum(jax.nn.one_hot(expert_id, N_EXPERTS, dtype=jnp.float32) * gates[..., None], axis=1)
    combine = combine.astype(t.dtype)
    out = jnp.zeros_like(t)
    for e in range(N_EXPERTS):
        y = (jax.nn.silu(t @ e_gate[e]) * (t @ e_up[e])) @ e_down[e]
        out = out + combine[:, e:e + 1] * y
    return out.reshape(B, S, D)


def hybrid_layer(x, norm1_g, w_in, nat_bias, swa_sink, pool_w, pool_scale, w_out,
                 norm2_g, rg_w, rg_b, re_w, re_b, e_gate, e_up, e_down):
    B, S, _ = x.shape
    h = rmsnorm(x, norm1_g)
    proj = h @ w_in
    splits = [int(v) for v in np.cumsum([D_A, D_A, D_A, D_B, D_BKV, D_BKV])]
    aq, ak, av, bq, bk, bv, cu = jnp.split(proj, splits, axis=-1)
    na = lambda a: a.reshape(B, S, NA_HEADS, HEAD_DIM)
    o_a = neighbourhood_attention(na(aq), na(ak), na(av), nat_bias)
    o_b = sliding_window_gqa(bq.reshape(B, S, SWA_Q_HEADS, HEAD_DIM),
                             bk.reshape(B, S, SWA_KV_HEADS, HEAD_DIM),
                             bv.reshape(B, S, SWA_KV_HEADS, HEAD_DIM), swa_sink)
    o_c = multiscale_pool(cu, pool_w, pool_scale)
    x = x + jnp.concatenate([o_a, o_b, o_c], axis=-1) @ w_out
    x = x + hierarchical_moe(rmsnorm(x, norm2_g), rg_w, rg_b, re_w, re_b, e_gate, e_up, e_down)
    return x


def setup_inputs(seed: int = 0) -> dict:
    key = jax.random.key(seed)
    ks = jax.random.split(key, 17)
    n = jax.random.normal
    f32 = jnp.float32
    return {
        'x': n(ks[0], (BATCH, SEQ, D_MODEL), f32),
        'norm1_g': 1.0 + 0.05 * n(ks[1], (DEPTH, D_MODEL), f32),
        'w_in': n(ks[2], (DEPTH, D_MODEL, D_IN), f32) * D_MODEL ** -0.5,
        'nat_bias': 0.2 * n(ks[3], (DEPTH, NA_HEADS, 2 * NA_ROWS_MAX - 1, 2 * NA_COLS - 1), f32),
        'swa_sink': n(ks[4], (DEPTH, SWA_Q_HEADS), f32),
        'pool_w': n(ks[5], (DEPTH, len(POOL_WINDOWS), POOL_GROUP_DIM, POOL_GROUP_DIM), f32) * POOL_GROUP_DIM ** -0.5,
        'pool_scale': 1.0 + 0.1 * n(ks[6], (DEPTH, D_C), f32),
        'w_out': n(ks[7], (DEPTH, D_MIX, D_MODEL), f32) * D_MIX ** -0.5,
        'norm2_g': 1.0 + 0.05 * n(ks[8], (DEPTH, D_MODEL), f32),
        'router_g_w': n(ks[9], (DEPTH, D_MODEL, N_GROUPS), f32) * D_MODEL ** -0.5,
        'router_g_b': 0.01 * n(ks[10], (DEPTH, N_GROUPS), f32),
        'router_e_w': n(ks[11], (DEPTH, D_MODEL, N_EXPERTS), f32) * D_MODEL ** -0.5,
        'router_e_b': 0.01 * n(ks[12], (DEPTH, N_EXPERTS), f32),
        'expert_w_gate': n(ks[13], (DEPTH, N_EXPERTS, D_MODEL, D_EXPERT), f32) * D_MODEL ** -0.5,
        'expert_w_up': n(ks[14], (DEPTH, N_EXPERTS, D_MODEL, D_EXPERT), f32) * D_MODEL ** -0.5,
        'expert_w_down': n(ks[15], (DEPTH, N_EXPERTS, D_EXPERT, D_MODEL), f32) * D_EXPERT ** -0.5,
        'final_g': 1.0 + 0.05 * n(ks[16], (D_MODEL,), f32),
    }


def reference(x, norm1_g, w_in, nat_bias, swa_sink, pool_w, pool_scale, w_out, norm2_g,
              router_g_w, router_g_b, router_e_w, router_e_b, expert_w_gate, expert_w_up,
              expert_w_down, final_g):
    for l in range(DEPTH):
        x = hybrid_layer(x, norm1_g[l], w_in[l], nat_bias[l], swa_sink[l], pool_w[l], pool_scale[l],
                         w_out[l], norm2_g[l], router_g_w[l], router_g_b[l], router_e_w[l],
                         router_e_b[l], expert_w_gate[l], expert_w_up[l], expert_w_down[l])
    return rmsnorm(x, final_g)
```

```cpp
#include <hip/hip_runtime.h>
#include <cstdio>
#include <cstdint>

__device__ __forceinline__ int launder_v(int v) { asm volatile("" : "+v"(v)); return v; }
namespace pg8 {
#define PG8_LAS __attribute__((address_space(3)))
typedef unsigned short bf16_t;
typedef short bf16x8 __attribute__((ext_vector_type(8)));
typedef float f32x4 __attribute__((ext_vector_type(4)));
typedef unsigned u32x4 __attribute__((ext_vector_type(4)));
typedef unsigned u32x2 __attribute__((ext_vector_type(2)));
constexpr int BM = 256, BK = 64, HALF = 128, HTB = HALF * BK * 2  , STAGE_BYTES = 8 * HTB, NXCD = 8, WGM = 8;

__host__ __device__ __forceinline__ int lds_byte(int r, int c) { const int st = (r >> 4) * 2 + (c >> 5), rr = r & 15, cc = c & 31, ob = rr * 64 + cc * 2; return st * 1024 + (ob ^ (((ob >> 9) & 1) << 5)); }
__host__ __device__ __forceinline__ void stage_rc(int b, int& R, int& C) { const int st = b / 1024, sb = b % 1024, swz = sb ^ (((sb >> 9) & 1) << 5); R = (st >> 1) * 16 + swz / 64; C = (st & 1) * 32 + (swz % 64) / 2; }
__host__ __device__ __forceinline__ int perm32(int rho) { const int n = rho >> 4, i = rho & 15; return 8 * (i >> 2) + 4 * n + (i & 3); }

struct Unit { int arow, brow, orow, ocol, rlim; };
struct Gemm { const bf16_t* A; const bf16_t* Bt; int K; };

struct StaticOrder {
    int nM, nN, nwg, G, c;
    __host__ __device__ void init(int M, int N, int G_, int c_) { nM = M / BM; nN = N / BM; nwg = nM * nN; G = G_; c = c_; }
    __host__ __device__ bool next(int i, Unit& u) const {
        const long L = (long)i * G + c; if (L >= nwg) return false;
        int wgid = (int)L; { const int q = nwg / NXCD, r = nwg % NXCD, xcd = wgid % NXCD, off = wgid / NXCD; wgid = (xcd < r ? xcd * (q + 1) : r * (q + 1) + (xcd - r) * q) + off; }
        const int nig = WGM * nN, gid = wgid / nig, fm = gid * WGM, gsz = (nM - fm) < WGM ? (nM - fm) : WGM;
        const int pm = fm + ((wgid % nig) % gsz), pn = (wgid % nig) / gsz;
        u.arow = pm * BM; u.orow = pm * BM; u.brow = pn * BM; u.ocol = pn * BM; u.rlim = 0x7fffffff; return true;
    }
    __device__ __forceinline__ void a_ready(const Unit&) const {}
    __device__ __forceinline__ void done(const Unit&) const {}
};

template <class Epi, class Sched, bool ALIGN_EPI = false, bool SP2 = false>
__device__ __forceinline__ void gemm_phase(PG8_LAS unsigned char* lds, const Gemm g, const Sched& S, const Epi& E) {
    const int tid = launder_v((int)threadIdx.x), wid = __builtin_amdgcn_readfirstlane(tid >> 6), lane = tid & 63, wr = wid >> 2, wc = wid & 3, fr = lane & 15, fq = lane >> 4;
    const int K = g.K, nt = K / BK;
    unsigned voffA[2], voffB[2];
#pragma unroll
    for (int i = 0; i < 2; ++i) { int R, C; stage_rc(tid * 16 + i * 8192, R, C); const int Rb = Epi::PERM ? ((R & ~31) + perm32(R & 31)) : R;
        voffA[i] = (unsigned)(R * K + C) * 2u; voffB[i] = (unsigned)(Rb * K + C) * 2u; }
    const size_t kstep = (size_t)(BK * 2);
    const size_t hstep = (size_t)HALF * K * 2;
    const size_t rowb = (size_t)K * 2;
    const unsigned ldsw = (unsigned)wid * 1024u;
    const int aoff = lds_byte(wr * 64 + fr, fq * 8), boff = lds_byte(wc * 32 + fr, fq * 8);
#define PG8_SA(b, h) (((b) * 2 + (h)) * HTB)
#define PG8_SB(b, h) ((4 + (b) * 2 + (h)) * HTB)
#define PG8_STAGE(bufoff, gbase, voff) do { _Pragma("unroll") for (int _i = 0; _i < 2; ++_i) \
        __builtin_amdgcn_global_load_lds((const unsigned*)((const char*)(gbase) + (voff)[_i]), (PG8_LAS unsigned*)(lds + (bufoff) + ldsw + _i * 8192), 16, 0, 0); } while (0)
#define PG8_LDA(dst, b, h) do { _Pragma("unroll") for (int m = 0; m < 4; ++m) _Pragma("unroll") for (int k = 0; k < 2; ++k) dst[m][k] = *(const PG8_LAS bf16x8*)(lds + PG8_SA(b, h) + aoff + m * 2048 + k * 1024); } while (0)
#define PG8_LDB(dst, b, h) do { _Pragma("unroll") for (int n = 0; n < 2; ++n) _Pragma("unroll") for (int k = 0; k < 2; ++k) dst[n][k] = *(const PG8_LAS bf16x8*)(lds + PG8_SB(b, h) + boff + n * 2048 + k * 1024); } while (0)
#define PG8_MMA(ai, bj, At, Bt) do { __builtin_amdgcn_s_setprio(1); _Pragma("unroll") for (int m = 0; m < 4; ++m) _Pragma("unroll") for (int n = 0; n < 2; ++n) _Pragma("unroll") for (int k = 0; k < 2; ++k) \
        acc[ai][bj][m][n] = __builtin_amdgcn_mfma_f32_16x16x32_bf16(Bt[n][k], At[m][k], acc[ai][bj][m][n], 0, 0, 0); __builtin_amdgcn_s_setprio(0); } while (0)
#define PG8_WAIT_V(n) asm volatile("s_waitcnt vmcnt(" #n ")" ::: "memory")
#define PG8_WAIT_L(n) asm volatile("s_waitcnt lgkmcnt(" #n ")" ::: "memory")
#define PG8_BAR __builtin_amdgcn_s_barrier()
#define PG8_SCHED __builtin_amdgcn_sched_barrier(0)
    Unit cur, nxt; int ui = 0;
    if (!S.next(0, cur)) return;
    f32x4 acc[2][2][4][2];
#pragma unroll
    for (int a = 0; a < 2; ++a)
#pragma unroll
        for (int b = 0; b < 2; ++b)
#pragma unroll
            for (int m = 0; m < 4; ++m)
#pragma unroll
                for (int n = 0; n < 2; ++n) acc[a][b][m][n] = (f32x4){0.f, 0.f, 0.f, 0.f};
    bf16x8 At[4][2], B0[2][2], B1[2][2];
    const char* cA = (const char*)g.A + (size_t)cur.arow * rowb; const char* cB = (const char*)g.Bt + (size_t)cur.brow * rowb;
    S.a_ready(cur);
    if constexpr (SP2) {
        PG8_STAGE(PG8_SB(0, 0), cB, voffB); PG8_STAGE(PG8_SB(0, 1), cB + hstep, voffB); PG8_STAGE(PG8_SA(0, 0), cA, voffA); PG8_STAGE(PG8_SA(0, 1), cA + hstep, voffA);
        if (wr == 1) PG8_BAR;
        PG8_WAIT_V(2); PG8_BAR;
        PG8_STAGE(PG8_SB(1, 0), cB + kstep, voffB); PG8_STAGE(PG8_SA(1, 0), cA + kstep, voffA); PG8_STAGE(PG8_SB(1, 1), cB + hstep + kstep, voffB);
        PG8_WAIT_V(6); PG8_BAR;
    } else {
        PG8_STAGE(PG8_SB(0, 0), cB, voffB); PG8_STAGE(PG8_SA(0, 0), cA, voffA); PG8_STAGE(PG8_SB(0, 1), cB + hstep, voffB); PG8_STAGE(PG8_SA(0, 1), cA + hstep, voffA);
        if (wr == 1) PG8_BAR;
        PG8_WAIT_V(4); PG8_BAR;
        PG8_STAGE(PG8_SB(1, 0), cB + kstep, voffB); PG8_STAGE(PG8_SA(1, 0), cA + kstep, voffA); PG8_STAGE(PG8_SB(1, 1), cB + hstep + kstep, voffB);
        PG8_WAIT_V(6); PG8_BAR;
    }
    for (;;) {
        const bool has_next = S.next(ui + 1, nxt);
        const char* nA = has_next ? (const char*)g.A + (size_t)nxt.arow * rowb : cA; const char* nB = has_next ? (const char*)g.Bt + (size_t)nxt.brow * rowb : cB;
        for (int t = 0; t < nt; t += 2) {
            const bool last = (t == nt - 2);
            const char* a1 = cA + (size_t)(t + 1) * kstep;
            const char* a2 = last ? nA : cA + (size_t)(t + 2) * kstep; const char* b2 = last ? nB : cB + (size_t)(t + 2) * kstep;
            const char* a3 = a2 + kstep; const char* b3 = b2 + kstep;
            if (last && has_next) S.a_ready(nxt);
            if constexpr (SP2) {
            PG8_LDB(B0, 0, 0); PG8_LDB(B1, 0, 1); PG8_SCHED; PG8_LDA(At, 0, 0); PG8_STAGE(PG8_SA(1, 1), a1 + hstep, voffA);
            PG8_WAIT_V(8); PG8_WAIT_L(0); PG8_BAR; PG8_MMA(0, 0, At, B0); PG8_MMA(0, 1, At, B1); PG8_BAR; PG8_SCHED;
            PG8_LDA(At, 0, 1); PG8_STAGE(PG8_SB(0, 0), b2, voffB); PG8_STAGE(PG8_SB(0, 1), b2 + hstep, voffB); PG8_STAGE(PG8_SA(0, 0), a2, voffA);
            PG8_WAIT_V(8); PG8_WAIT_L(0); PG8_BAR; PG8_MMA(1, 0, At, B0); PG8_MMA(1, 1, At, B1); PG8_BAR; PG8_SCHED;
            PG8_LDB(B0, 1, 0); PG8_LDB(B1, 1, 1); PG8_SCHED; PG8_LDA(At, 1, 0); PG8_STAGE(PG8_SA(0, 1), a2 + hstep, voffA);
            PG8_WAIT_V(8); PG8_WAIT_L(0); PG8_BAR; PG8_MMA(0, 0, At, B0); PG8_MMA(0, 1, At, B1); PG8_BAR; PG8_SCHED;
            PG8_LDA(At, 1, 1); PG8_STAGE(PG8_SB(1, 0), b3, voffB); PG8_STAGE(PG8_SB(1, 1), b3 + hstep, voffB); PG8_STAGE(PG8_SA(1, 0), a3, voffA);
            PG8_WAIT_V(8); PG8_WAIT_L(0); PG8_BAR; PG8_MMA(1, 0, At, B0); PG8_MMA(1, 1, At, B1); PG8_BAR; PG8_SCHED;
            } else {
            PG8_LDB(B0, 0, 0); PG8_SCHED; PG8_LDA(At, 0, 0); PG8_STAGE(PG8_SA(1, 1), a1 + hstep, voffA);
            PG8_WAIT_L(8); PG8_BAR; PG8_WAIT_L(0); PG8_MMA(0, 0, At, B0); PG8_BAR; PG8_SCHED;
            PG8_LDB(B1, 0, 1); PG8_STAGE(PG8_SB(0, 0), b2, voffB);
            PG8_BAR; PG8_WAIT_L(0); PG8_MMA(0, 1, At, B1); PG8_BAR;
            PG8_LDA(At, 0, 1); PG8_STAGE(PG8_SA(0, 0), a2, voffA);
            PG8_BAR; PG8_WAIT_L(0); PG8_MMA(1, 0, At, B0); PG8_BAR; PG8_SCHED;
            PG8_STAGE(PG8_SB(0, 1), b2 + hstep, voffB);
            PG8_WAIT_V(6); PG8_BAR; PG8_MMA(1, 1, At, B1); PG8_BAR;
            PG8_LDB(B0, 1, 0); PG8_SCHED; PG8_LDA(At, 1, 0); PG8_STAGE(PG8_SA(0, 1), a2 + hstep, voffA);
            PG8_WAIT_L(8); PG8_BAR; PG8_WAIT_L(0); PG8_MMA(0, 0, At, B0); PG8_BAR; PG8_SCHED;
            PG8_LDB(B1, 1, 1); PG8_STAGE(PG8_SB(1, 0), b3, voffB);
            PG8_BAR; PG8_WAIT_L(0); PG8_MMA(0, 1, At, B1); PG8_BAR;
            PG8_LDA(At, 1, 1); PG8_STAGE(PG8_SA(1, 0), a3, voffA);
            PG8_BAR; PG8_WAIT_L(0); PG8_MMA(1, 0, At, B0); PG8_BAR; PG8_SCHED;
            PG8_STAGE(PG8_SB(1, 1), b3 + hstep, voffB);
            PG8_WAIT_V(6); PG8_BAR; PG8_MMA(1, 1, At, B1); PG8_BAR;
            }
        }
        if constexpr (ALIGN_EPI) { if (wr == 0) PG8_BAR; }
        if constexpr (!Epi::AFTER_DRAIN) { E(acc, cur, wr, wc, fr, fq); S.done(cur); }
        if (!has_next) break;
#pragma unroll
        for (int a = 0; a < 2; ++a)
#pragma unroll
            for (int b = 0; b < 2; ++b)
#pragma unroll
                for (int m = 0; m < 4; ++m)
#pragma unroll
                    for (int n = 0; n < 2; ++n) acc[a][b][m][n] = (f32x4){0.f, 0.f, 0.f, 0.f};
        cur = nxt; cA = nA; cB = nB; ++ui;
        if constexpr (ALIGN_EPI) { if (wr == 1) PG8_BAR; }
    }
    PG8_WAIT_V(0);
    if constexpr (!ALIGN_EPI) { if (wr == 0) PG8_BAR; }
    PG8_BAR;
    if constexpr (Epi::AFTER_DRAIN) { E.fused(acc, cur, wr, wc, fr, fq, lds, wid, lane); S.done(cur); }
#undef PG8_SA
#undef PG8_SB
#undef PG8_STAGE
#undef PG8_LDA
#undef PG8_LDB
#undef PG8_MMA
#undef PG8_WAIT_V
#undef PG8_WAIT_L
#undef PG8_BAR
#undef PG8_SCHED
}
}

using pg8::bf16_t; using pg8::bf16x8; using pg8::f32x4; using pg8::u32x4; using pg8::u32x2;
#define GAS __attribute__((address_space(1)))
#define LAS __attribute__((address_space(3)))
typedef GAS unsigned gu32;
#define RLX_AGENT __ATOMIC_RELAXED, __HIP_MEMORY_SCOPE_AGENT
#define LDS_WAIT() asm volatile("s_waitcnt lgkmcnt(0)" ::: "memory")
#define VM_WAIT() asm volatile("s_waitcnt vmcnt(0)" ::: "memory")

constexpr int NWAVES = 8, NTHR = 512;
constexpr int BATCH = 2, SEQ = 8192, T = BATCH * SEQ, D = 1024, DIN = 1792, NE = 32, DE = 256, DEPTH = 2;
constexpr float RMS_EPS = 1e-6f;
constexpr int C_AQ = 0, C_AK = 256, C_AV = 512, C_BQ = 768, C_BK = 1280, C_BV = 1408, C_CU = 1536;
constexpr int NROWS2 = 2 * T + 256;

constexpr size_t MiB = 1u << 20;
constexpr size_t WS_CTL = 0, CTL_ZERO_BYTES = 1 * MiB;
constexpr size_t WS_WRH = 1 * MiB;
constexpr size_t WS_WRL = WS_WRH + 2 * 48 * 1024 * 2;
constexpr size_t WS_PW = WS_WRL + 2 * 48 * 1024 * 2;
constexpr size_t WS_TOKE = 2 * MiB;
constexpr size_t WS_TOKG = WS_TOKE + (size_t)T * 8;
constexpr size_t WS_TOKR = WS_TOKG + (size_t)T * 8;
constexpr size_t WS_W = 4 * MiB, W_LAYER = 54 * MiB;
constexpr size_t W_IN = 0, W_OUT = (size_t)DIN * D * 2, W_GU = W_OUT + (size_t)D * D * 2, W_DN = W_GU + (size_t)NE * 512 * D * 2, W_END = W_DN + (size_t)NE * D * DE * 2;
static_assert(W_END <= W_LAYER, "weights");
constexpr size_t WS_H = 112 * MiB;
constexpr size_t WS_PROJ = 144 * MiB;
constexpr size_t WS_VTA = 200 * MiB;
constexpr size_t WS_VTB = 208 * MiB;
constexpr size_t WS_MIX = 212 * MiB;
constexpr size_t WS_HS = 144 * MiB;
constexpr size_t WS_ACT = 212 * MiB;
constexpr size_t WS_END = 244 * MiB;
static_assert(WS_W + 2 * W_LAYER <= WS_H && WS_H + (size_t)T * D * 2 <= WS_PROJ && WS_PROJ + (size_t)T * DIN * 2 <= WS_VTA, "ws map 1");
static_assert(WS_HS + (size_t)NROWS2 * D * 2 <= WS_ACT && WS_ACT + (size_t)NROWS2 * DE * 2 <= WS_END && WS_MIX + (size_t)T * D * 2 <= WS_END, "ws map 2");
constexpr int CW_BAR = 4096, CW_CNT = 8192;

constexpr int RING_BYTES = 131072, LDSCTL_OFF = RING_BYTES, MISC_OFF = LDSCTL_OFF + 320, SCHED_OFF = LDSCTL_OFF + 1024, LDS_BYTES = 147456;

__device__ __forceinline__ unsigned pk2(float lo, float hi) {
    typedef float f2 __attribute__((ext_vector_type(2))); typedef __bf16 b2 __attribute__((ext_vector_type(2)));
    f2 v = {lo, hi}; b2 b = __builtin_convertvector(v, b2); return __builtin_bit_cast(unsigned, b); }
__device__ __forceinline__ float bflo(unsigned w) { return __uint_as_float(w << 16); }
__device__ __forceinline__ float bfhi(unsigned w) { return __uint_as_float(w & 0xffff0000u); }
__device__ __forceinline__ float wave_sum(float v) {
#pragma unroll
    for (int o = 1; o < 64; o <<= 1) v += __shfl_xor(v, o);
    return v;
}
__device__ __forceinline__ int launder_i(int v) { asm volatile("" : "+s"(v)); return v; }
template <class P> __device__ __forceinline__ P* launder_p(P* p) { asm volatile("" : "+s"(p)); return p; }
constexpr int ARGS_OFF = LDSCTL_OFF + 2048;
__device__ __forceinline__ unsigned long long arg_u64(LAS unsigned char* lds, int k) {
    const LAS unsigned* p = (const LAS unsigned*)(lds + ARGS_OFF) + 2 * k;
    const unsigned lo = __builtin_amdgcn_readfirstlane(p[0]), hi = __builtin_amdgcn_readfirstlane(p[1]);
    return ((unsigned long long)hi << 32) | lo; }
#define ARGF(k) ((const float*)arg_u64(lds, (k)))
#define WSP() ((unsigned char*)arg_u64(lds, 18))
__device__ __forceinline__ f32x4 mfma16(bf16x8 a, bf16x8 b, f32x4 c) { return __builtin_amdgcn_mfma_f32_16x16x32_bf16(a, b, c, 0, 0, 0); }

#define XB_TMO      128
#define XB_XCNT(j)  (256  + 64 * (j))
#define XB_XSUB(j)  (1280 + 64 * (j))
#define XB_XGEN(j)  (2304 + 64 * (j))
#define XB_TOP      3328
#define XB_TOPGEN   3392
#define XCD_BAR_WORDS 3456
#define XB_SPIN_CAP (1u << 18)

__device__ __forceinline__ unsigned xb_ld(unsigned* p)              { return __hip_atomic_load(p, __ATOMIC_RELAXED, __HIP_MEMORY_SCOPE_AGENT); }
__device__ __forceinline__ unsigned xb_add(unsigned* p, unsigned v) { return __hip_atomic_fetch_add(p, v, __ATOMIC_RELAXED, __HIP_MEMORY_SCOPE_AGENT); }
__device__ __forceinline__ unsigned xb_xcc_id() { return (unsigned)__builtin_amdgcn_s_getreg((3 << 11) | 20) & 0xFu; }
#define XB_SPIN(cond, bar) do { unsigned _sp = 0; while (cond) { __builtin_amdgcn_s_sleep(1); \
    if ((++_sp & 255u) == 0u) { if (xb_ld(&(bar)[XB_TMO])) break; if (_sp > XB_SPIN_CAP) { atomicAdd(&(bar)[XB_TMO], 1u); break; } } } } while (0)

struct XcdBarrier {
    unsigned* bar; unsigned x;
    volatile LAS unsigned* st;
};

__device__ __forceinline__ XcdBarrier xcd_barrier_post(unsigned* bar, volatile LAS unsigned* st) {
    XcdBarrier b; b.bar = bar; b.x = xb_xcc_id(); b.st = st;
    if (threadIdx.x == 0) (void)xb_add(&bar[XB_XCNT(b.x)], 1u);
    return b;
}
__device__ __forceinline__ void xcd_barrier_complete(unsigned* bar, unsigned x, unsigned& nloc, unsigned& nx) {
    const unsigned G = gridDim.x * gridDim.y * gridDim.z;
    unsigned sum, cnt, mine, sp = 0u;
    for (;;) {
        sum = 0u; cnt = 0u;
#pragma unroll 1
        for (unsigned j = 0; j < 16; ++j) { const unsigned c = xb_ld(&bar[XB_XCNT(j)]); sum += c; cnt += (c > 0u) ? 1u : 0u; }
        mine = xb_ld(&bar[XB_XCNT(x)]);
        if (sum == G) break;
        __builtin_amdgcn_s_sleep(1);
        if ((++sp & 255u) == 0u) { if (xb_ld(&bar[XB_TMO])) break; if (sp > XB_SPIN_CAP) { atomicAdd(&bar[XB_TMO], 1u); break; } }
    }
    nloc = mine > 0u ? mine : 1u; nx = cnt > 0u ? cnt : 1u;
}

__device__ __forceinline__ void xcd_barrier(const XcdBarrier& b) {
    asm volatile("s_waitcnt vmcnt(0)" ::: "memory");
    __syncthreads();
    if (threadIdx.x == 0) {
        unsigned* bar = b.bar;
        __builtin_amdgcn_s_waitcnt(0);
        unsigned nloc = b.st[0], nx = b.st[1];
        if (nloc == 0u) { xcd_barrier_complete(bar, b.x, nloc, nx); b.st[0] = nloc; b.st[1] = nx; }
        const unsigned old = xb_add(&bar[XB_XSUB(b.x)], 1u);
        const unsigned gen = old / nloc;
        if (old + 1u == (gen + 1u) * nloc) {
            __builtin_amdgcn_fence(__ATOMIC_RELEASE, "agent");
            asm volatile("s_waitcnt vmcnt(0)" ::: "memory");
            const unsigned og = xb_add(&bar[XB_TOP], 1u);
            const unsigned tg = og / nx;
            if (og + 1u == (tg + 1u) * nx) xb_add(&bar[XB_TOPGEN], 1u);
            else XB_SPIN(xb_ld(&bar[XB_TOPGEN]) == tg, bar);
            __builtin_amdgcn_fence(__ATOMIC_ACQUIRE, "agent");
            xb_add(&bar[XB_XGEN(b.x)], 1u);
            asm volatile("s_waitcnt vmcnt(0)" ::: "memory");
        } else {
            XB_SPIN(xb_ld(&bar[XB_XGEN(b.x)]) == gen, bar);
            __builtin_amdgcn_fence(__ATOMIC_ACQUIRE, "agent");
            asm volatile("s_waitcnt vmcnt(0)" ::: "memory");
        }
    }
    __syncthreads();
}


namespace pg8 {
struct EpiProj {
    static constexpr bool PERM = true, AFTER_DRAIN = false;
    bf16_t* P; bf16_t* VTa; bf16_t* VTb;
    __device__ __forceinline__ void operator()(const f32x4 (&acc)[2][2][4][2], const Unit& u, int wr, int wc, int fr, int fq) const {
        const int row0 = u.orow + wr * 64 + fr;
#pragma unroll
        for (int bj = 0; bj < 2; ++bj) {
            const int cb = u.ocol + bj * HALF, blk = cb >> 7;
            const int col0 = cb + wc * 32 + 8 * fq;
            if (blk == 4 || blk == 5 || blk == 11) {
                bf16_t* vt; int cl, nh;
                if (blk == 11) { vt = VTb; cl = col0 - C_BV; nh = 2; } else { vt = VTa; cl = col0 - C_AV; nh = 4; }
                const int head = cl >> 6, d0 = cl & 63;
#pragma unroll
                for (int ai = 0; ai < 2; ++ai)
#pragma unroll
                    for (int m = 0; m < 4; ++m) {
                        const int r = row0 + ai * HALF + m * 16, b = r >> 13, t = r & (SEQ - 1);
                        GAS bf16_t* p = (GAS bf16_t*)(vt + ((size_t)((b * nh + head) * 64 + d0)) * SEQ + t);
#pragma unroll
                        for (int n = 0; n < 2; ++n) { const f32x4 v = acc[ai][bj][m][n]; const unsigned w0 = pk2(v[0], v[1]), w1 = pk2(v[2], v[3]);
                            p[(size_t)(4 * n + 0) * SEQ] = (bf16_t)(w0 & 0xffffu); p[(size_t)(4 * n + 1) * SEQ] = (bf16_t)(w0 >> 16);
                            p[(size_t)(4 * n + 2) * SEQ] = (bf16_t)(w1 & 0xffffu); p[(size_t)(4 * n + 3) * SEQ] = (bf16_t)(w1 >> 16); }
                    }
            } else {
                const float sc = (blk <= 1 || (blk >= 6 && blk <= 9)) ? 0.125f : 1.0f;
#pragma unroll
                for (int ai = 0; ai < 2; ++ai)
#pragma unroll
                    for (int m = 0; m < 4; ++m) {
                        bf16_t* rowp = P + (size_t)(row0 + ai * HALF + m * 16) * DIN + col0;
                        const f32x4 v0 = acc[ai][bj][m][0] * sc, v1 = acc[ai][bj][m][1] * sc;
                        u32x4 w; w.x = pk2(v0[0], v0[1]); w.y = pk2(v0[2], v0[3]); w.z = pk2(v1[0], v1[1]); w.w = pk2(v1[2], v1[3]);
                        *(GAS u32x4*)rowp = w;
                    }
            }
        }
    }
};
struct EpiResid {
    static constexpr bool PERM = false, AFTER_DRAIN = false;
    const float* xin; float* X;
    __device__ __forceinline__ void operator()(const f32x4 (&acc)[2][2][4][2], const Unit& u, int wr, int wc, int fr, int fq) const {
        const int row0 = u.orow + wr * 64 + fr, col0 = u.ocol + wc * 32 + 4 * fq;
#pragma unroll
        for (int ai = 0; ai < 2; ++ai)
#pragma unroll
            for (int m = 0; m < 4; ++m) { const size_t off = (size_t)(row0 + ai * HALF + m * 16) * D + col0;
#pragma unroll
                for (int bj = 0; bj < 2; ++bj)
#pragma unroll
                    for (int n = 0; n < 2; ++n) { const f32x4 b = *(const GAS f32x4*)(xin + off + bj * HALF + n * 16); *(GAS f32x4*)(X + off + bj * HALF + n * 16) = b + acc[ai][bj][m][n]; } }
    }
};
struct EpiAct {
    static constexpr bool PERM = true, AFTER_DRAIN = false;
    bf16_t* A;
    __device__ __forceinline__ void operator()(const f32x4 (&acc)[2][2][4][2], const Unit& u, int wr, int wc, int fr, int fq) const {
        const int row0 = u.orow + wr * 64 + fr, col0 = (u.ocol >> 1) + wc * 32 + 8 * fq;
#pragma unroll
        for (int ai = 0; ai < 2; ++ai)
#pragma unroll
            for (int m = 0; m < 4; ++m) { const int r = row0 + ai * HALF + m * 16;
                float o[8];
#pragma unroll
                for (int n = 0; n < 2; ++n)
#pragma unroll
                    for (int e = 0; e < 4; ++e) { const float g = acc[ai][0][m][n][e], uu = acc[ai][1][m][n][e];
                        o[4 * n + e] = g * __builtin_amdgcn_rcpf(1.0f + __expf(-g)) * uu; }
                u32x4 w; w.x = pk2(o[0], o[1]); w.y = pk2(o[2], o[3]); w.z = pk2(o[4], o[5]); w.w = pk2(o[6], o[7]);
                if (r < u.rlim) *(GAS u32x4*)(A + (size_t)r * DE + col0) = w; }
    }
};
struct EpiY {
    static constexpr bool PERM = true, AFTER_DRAIN = false;
    bf16_t* Y;
    __device__ __forceinline__ void operator()(const f32x4 (&acc)[2][2][4][2], const Unit& u, int wr, int wc, int fr, int fq) const {
        const int row0 = u.orow + wr * 64 + fr, col0 = u.ocol + wc * 32 + 8 * fq;
#pragma unroll
        for (int ai = 0; ai < 2; ++ai)
#pragma unroll
            for (int m = 0; m < 4; ++m) { const int r = row0 + ai * HALF + m * 16;
#pragma unroll
                for (int bj = 0; bj < 2; ++bj) { const f32x4 v0 = acc[ai][bj][m][0], v1 = acc[ai][bj][m][1];
                    u32x4 w; w.x = pk2(v0[0], v0[1]); w.y = pk2(v0[2], v0[3]); w.z = pk2(v1[0], v1[1]); w.w = pk2(v1[2], v1[3]);
                    if (r < u.rlim) *(GAS u32x4*)(Y + (size_t)r * D + col0 + bj * HALF) = w; } }
    }
};
struct GroupedOrder {
    const LAS int* off; const LAS int* tpre; int lnp, brows, G, c;
    __device__ __forceinline__ bool next(int i, Unit& u) const {
        const int total = __builtin_amdgcn_readfirstlane(tpre[NE]) << lnp;
        const long L = (long)i * G + c; if (L >= total) return false;
        const int l = (int)L, pn = l & ((1 << lnp) - 1), tau = l >> lnp;
        int e = 0;
        for (int k = 1; k < NE; ++k) e += (__builtin_amdgcn_readfirstlane(tpre[k]) <= tau) ? 1 : 0;
        const int m = tau - __builtin_amdgcn_readfirstlane(tpre[e]);
        u.arow = __builtin_amdgcn_readfirstlane(off[e]) + BM * m; u.orow = u.arow; u.brow = e * brows + BM * pn; u.ocol = BM * pn;
        u.rlim = __builtin_amdgcn_readfirstlane(off[e + 1]); return true;
    }
    __device__ __forceinline__ void a_ready(const Unit&) const {}
    __device__ __forceinline__ void done(const Unit&) const {}
};
}

struct Args { const float* in[17]; float* out; unsigned char* ws; };
enum { I_X = 0, I_N1G, I_WIN, I_NATB, I_SINK, I_POOLW, I_POOLS, I_WOUT, I_N2G, I_RGW, I_RGB, I_REW, I_REB, I_EG, I_EU, I_ED, I_FG };

__device__ __forceinline__ void transpose_item(const float* W, int ldw, int k0, int n0, bf16_t* WT, int ldt, int drow0, LAS float* scr, int lane) {
    const GAS float* Wg = (const GAS float*)W;
#pragma unroll 8
    for (int i = 0; i < 32; ++i) { const int kk = 2 * i + (lane >> 5); scr[kk * 33 + (lane & 31)] = Wg[(size_t)(k0 + kk) * ldw + n0 + (lane & 31)]; }
    LDS_WAIT(); asm volatile("" ::: "memory");
    const int c = lane & 7;
#pragma unroll
    for (int j = 0; j < 4; ++j) { const int n = (lane >> 3) + 8 * j; const LAS float* s = scr + (8 * c) * 33 + n;
        u32x4 o; o.x = pk2(s[0 * 33], s[1 * 33]); o.y = pk2(s[2 * 33], s[3 * 33]); o.z = pk2(s[4 * 33], s[5 * 33]); o.w = pk2(s[6 * 33], s[7 * 33]);
        *(GAS u32x4*)(WT + (size_t)(drow0 + n) * ldt + k0 + 8 * c) = o; }
    LDS_WAIT(); asm volatile("" ::: "memory");
}
__device__ __forceinline__ void norm_row_bf16(const float* xrow, const float* g, bf16_t* orow, int lane) {
    const GAS f32x4* xr = (const GAS f32x4*)xrow + lane; const GAS f32x4* gr = (const GAS f32x4*)g + lane;
    f32x4 v[4]; float s = 0.f;
#pragma unroll
    for (int j = 0; j < 4; ++j) { v[j] = xr[64 * j]; s += (v[j].x * v[j].x + v[j].y * v[j].y) + (v[j].z * v[j].z + v[j].w * v[j].w); }
    const float rstd = 1.0f / sqrtf(wave_sum(s) * (1.0f / D) + RMS_EPS);
    GAS u32x2* o8 = (GAS u32x2*)orow + lane;
#pragma unroll
    for (int j = 0; j < 4; ++j) { const f32x4 gg = gr[64 * j]; u32x2 w; w.x = pk2(v[j].x * rstd * gg.x, v[j].y * rstd * gg.y); w.y = pk2(v[j].z * rstd * gg.z, v[j].w * rstd * gg.w); o8[64 * j] = w; }
}

__device__ __forceinline__ void p0_prologue(LAS unsigned char* lds, int gw, int NGW, int wave, int lane) {
    unsigned char* ws = WSP();
    LAS float* scr = (LAS float*)(lds + wave * 16384);
    constexpr int I0 = 16 * 56, I1 = 16 * 32, I2 = NE * 128, I3 = NE * 128, I4 = NE * 128, I5 = 8, IL = I0 + I1 + I2 + I3 + I4 + I5;
    for (int it = gw; it < DEPTH * IL; it += NGW) {
        const int l = it / IL; int r = it - l * IL;
        unsigned char* wl = ws + WS_W + (size_t)l * W_LAYER;
        if (r < I0) { const int kb = r / 56, nb = r % 56; transpose_item(ARGF(I_WIN) + (size_t)l * D * DIN, DIN, 64 * kb, 32 * nb, (bf16_t*)(wl + W_IN), D, 32 * nb, scr, lane); continue; } r -= I0;
        if (r < I1) { const int kb = r / 32, nb = r % 32; transpose_item(ARGF(I_WOUT) + (size_t)l * D * D, D, 64 * kb, 32 * nb, (bf16_t*)(wl + W_OUT), D, 32 * nb, scr, lane); continue; } r -= I1;
        if (r < I2 + I3) { const int up = r >= I2; if (up) r -= I2; const int e = r >> 7, q = r & 127, kb = q >> 3, nb = q & 7, n0 = 32 * nb;
            const float* W = ARGF(up ? I_EU : I_EG) + (size_t)(l * NE + e) * D * DE;
            transpose_item(W, DE, 64 * kb, n0, (bf16_t*)(wl + W_GU), D, e * 512 + 256 * (n0 >> 7) + (n0 & 127) + (up ? 128 : 0), scr, lane); continue; } r -= I2 + I3;
        if (r < I4) { const int e = r >> 7, q = r & 127, kb = q >> 5, nb = q & 31;
            transpose_item(ARGF(I_ED) + (size_t)(l * NE + e) * DE * D, D, 64 * kb, 32 * nb, (bf16_t*)(wl + W_DN) + (size_t)e * D * DE, DE, 32 * nb, scr, lane); continue; } r -= I4;
        { const int gi = r >> 1, nb = r & 1;
            transpose_item(ARGF(I_POOLW) + (size_t)(l * 4 + gi) * 64 * 64, 64, 0, 32 * nb, (bf16_t*)(ws + WS_PW) + (size_t)(l * 4 + gi) * 64 * 64, 64, 32 * nb, scr, lane); }
    }
    for (int idx = gw * 64 + lane; idx < DEPTH * 48 * 1024; idx += NGW * 64) {
        const int l = idx / (48 * 1024), rem = idx - l * 48 * 1024, rho = rem >> 10, k = rem & 1023;
        float w;
        if (rho < 16) w = ARGF(I_RGW)[((size_t)l * D + k) * 4 + (rho & 3)];
        else { const int q = (rho - 16) & 15, e = 8 * (q >> 2) + (q & 3) + (rho >= 32 ? 4 : 0); w = ARGF(I_REW)[((size_t)l * D + k) * NE + e]; }
        w *= ARGF(I_N2G)[l * D + k];
        const unsigned h = pk2(w, 0.f) & 0xffffu; const float lo = w - bflo(h);
        ((bf16_t*)(ws + WS_WRH))[idx] = (bf16_t)h; ((bf16_t*)(ws + WS_WRL))[idx] = (bf16_t)(pk2(lo, 0.f) & 0xffffu);
    }
    for (int m = gw; m < T; m += NGW) norm_row_bf16(ARGF(I_X) + (size_t)m * D, ARGF(I_N1G), (bf16_t*)(ws + WS_H) + (size_t)m * D, lane);
}

__device__ __forceinline__ void na_task(int task, const bf16_t* proj, const bf16_t* VTa, const float* natb, bf16_t* mix, int lane) {
    const int cb = task & 3, r = (task >> 2) & 127, h = (task >> 9) & 3, b = task >> 11;
    const int i = lane & 15, g = lane >> 4;
    const int c0 = cb * 16, wsx = (cb == 0) ? 0 : (cb == 1) ? 8 : (cb == 2) ? 24 : 32;
    const int rs = min(max(r - 4, 0), 120);
    const size_t tq = (size_t)b * SEQ + r * 64 + c0 + i;
    const bf16_t* qp = proj + tq * DIN + C_AQ + h * 64 + 8 * g;
    const bf16x8 q0 = *(const GAS bf16x8*)qp, q1 = *(const GAS bf16x8*)(qp + 32);
    f32x4 sc[8][2];
#pragma unroll
    for (int j = 0; j < 8; ++j) {
        const size_t tk0 = (size_t)b * SEQ + (rs + j) * 64 + wsx;
#pragma unroll
        for (int kb = 0; kb < 2; ++kb) {
            const int kk = 8 * (i >> 2) + 4 * kb + (i & 3);
            const bf16_t* kp = proj + (tk0 + kk) * DIN + C_AK + h * 64 + 8 * g;
            const bf16x8 k0 = *(const GAS bf16x8*)kp, k1 = *(const GAS bf16x8*)(kp + 32);
            f32x4 acc = {0.f, 0.f, 0.f, 0.f};
            acc = mfma16(k0, q0, acc); acc = mfma16(k1, q1, acc);
            sc[j][kb] = acc;
        }
    }
    const int c = c0 + i, cs = min(max(c - 8, 0), 48);
    const GAS float* nb = (const GAS float*)(natb + h * 15 * 31);
    float mx = -1e30f;
#pragma unroll
    for (int j = 0; j < 8; ++j) {
        const int dr = rs + j - r + 7;
#pragma unroll
        for (int kb = 0; kb < 2; ++kb)
#pragma unroll
            for (int e = 0; e < 4; ++e) {
                const int kc = wsx + 8 * g + 4 * kb + e; const bool valid = (kc >= cs) && (kc < cs + 16);
                const int dc = min(max(kc - c + 15, 0), 30);
                const float bias = nb[dr * 31 + dc];
                const float s = valid ? sc[j][kb][e] + bias : -1e30f;
                sc[j][kb][e] = s; mx = fmaxf(mx, s);
            }
    }
    mx = fmaxf(mx, __shfl_xor(mx, 16)); mx = fmaxf(mx, __shfl_xor(mx, 32));
    float sum = 0.f;
#pragma unroll
    for (int j = 0; j < 8; ++j)
#pragma unroll
        for (int kb = 0; kb < 2; ++kb)
#pragma unroll
            for (int e = 0; e < 4; ++e) { const float p = __expf(sc[j][kb][e] - mx); sc[j][kb][e] = p; sum += p; }
    sum += __shfl_xor(sum, 16); sum += __shfl_xor(sum, 32);
    f32x4 o[4];
#pragma unroll
    for (int db = 0; db < 4; ++db) o[db] = (f32x4){0.f, 0.f, 0.f, 0.f};
    const bf16_t* vbase = VTa + ((size_t)((b * 4 + h) * 64 + i)) * SEQ + 8 * g;
#pragma unroll
    for (int j = 0; j < 8; ++j) {
        u32x4 pw; pw.x = pk2(sc[j][0][0], sc[j][0][1]); pw.y = pk2(sc[j][0][2], sc[j][0][3]); pw.z = pk2(sc[j][1][0], sc[j][1][1]); pw.w = pk2(sc[j][1][2], sc[j][1][3]);
        const bf16x8 pb = __builtin_bit_cast(bf16x8, pw);
        const int tk = (rs + j) * 64 + wsx;
#pragma unroll
        for (int db = 0; db < 4; ++db) { const bf16x8 v = *(const GAS bf16x8*)(vbase + (size_t)(db * 16) * SEQ + tk); o[db] = mfma16(v, pb, o[db]); }
    }
    const float inv = 1.0f / sum;
    bf16_t* op = mix + tq * D + h * 64 + 4 * g;
#pragma unroll
    for (int db = 0; db < 4; ++db) { u32x2 w; w.x = pk2(o[db][0] * inv, o[db][1] * inv); w.y = pk2(o[db][2] * inv, o[db][3] * inv); *(GAS u32x2*)(op + db * 16) = w; }
}

__device__ __forceinline__ void swa_task(int task, const bf16_t* proj, const bf16_t* VTb, const float* sinkp, bf16_t* mix, int lane) {
    const int hq = task & 7, qb = (task >> 3) & 511, b = task >> 12;
    const int i = lane & 15, g = lane >> 4, kvh = hq >> 2;
    const int q0 = qb * 16, tqi = q0 + i;
    const size_t tq = (size_t)b * SEQ + tqi;
    const bf16_t* qp = proj + tq * DIN + C_BQ + hq * 64 + 8 * g;
    const bf16x8 qf0 = *(const GAS bf16x8*)qp, qf1 = *(const GAS bf16x8*)(qp + 32);
    const float slope = exp2f(-(float)(hq + 1));
    f32x4 sc[9][2];
#pragma unroll
    for (int j = 0; j < 9; ++j) {
        const int ks = q0 - 128 + 32 * j;
#pragma unroll
        for (int kb = 0; kb < 2; ++kb) {
            const int key = ks + 8 * (i >> 2) + 4 * kb + (i & 3), keyc = min(max(key, 0), SEQ - 1);
            const bf16_t* kp = proj + ((size_t)b * SEQ + keyc) * DIN + C_BK + kvh * 64 + 8 * g;
            const bf16x8 k0 = *(const GAS bf16x8*)kp, k1 = *(const GAS bf16x8*)(kp + 32);
            f32x4 acc = {0.f, 0.f, 0.f, 0.f};
            acc = mfma16(k0, qf0, acc); acc = mfma16(k1, qf1, acc);
            sc[j][kb] = acc;
        }
    }
    const float sink = sinkp[hq];
    float mx = sink;
#pragma unroll
    for (int j = 0; j < 9; ++j)
#pragma unroll
        for (int kb = 0; kb < 2; ++kb)
#pragma unroll
            for (int e = 0; e < 4; ++e) {
                const int key = q0 - 128 + 32 * j + 8 * g + 4 * kb + e; const int df = key - tqi, ad = df < 0 ? -df : df;
                const bool valid = (key >= 0) && (key < SEQ) && (ad <= 128);
                const float s = valid ? sc[j][kb][e] - slope * (float)ad : -1e30f;
                sc[j][kb][e] = s; mx = fmaxf(mx, s);
            }
    mx = fmaxf(mx, __shfl_xor(mx, 16)); mx = fmaxf(mx, __shfl_xor(mx, 32));
    float sum = 0.f;
#pragma unroll
    for (int j = 0; j < 9; ++j)
#pragma unroll
        for (int kb = 0; kb < 2; ++kb)
#pragma unroll
            for (int e = 0; e < 4; ++e) { const float p = __expf(sc[j][kb][e] - mx); sc[j][kb][e] = p; sum += p; }
    sum += __shfl_xor(sum, 16); sum += __shfl_xor(sum, 32);
    sum += __expf(sink - mx);
    f32x4 o[4];
#pragma unroll
    for (int db = 0; db < 4; ++db) o[db] = (f32x4){0.f, 0.f, 0.f, 0.f};
    const bf16_t* vbase = VTb + ((size_t)((b * 2 + kvh) * 64 + i)) * SEQ;
#pragma unroll
    for (int j = 0; j < 9; ++j) {
        u32x4 pw; pw.x = pk2(sc[j][0][0], sc[j][0][1]); pw.y = pk2(sc[j][0][2], sc[j][0][3]); pw.z = pk2(sc[j][1][0], sc[j][1][1]); pw.w = pk2(sc[j][1][2], sc[j][1][3]);
        const bf16x8 pb = __builtin_bit_cast(bf16x8, pw);
        const int tk = min(max(q0 - 128 + 32 * j + 8 * g, 0), SEQ - 8);
#pragma unroll
        for (int db = 0; db < 4; ++db) { const bf16x8 v = *(const GAS bf16x8*)(vbase + (size_t)(db * 16) * SEQ + tk); o[db] = mfma16(v, pb, o[db]); }
    }
    const float inv = 1.0f / sum;
    bf16_t* op = mix + tq * D + 256 + hq * 64 + 4 * g;
#pragma unroll
    for (int db = 0; db < 4; ++db) { u32x2 w; w.x = pk2(o[db][0] * inv, o[db][1] * inv); w.y = pk2(o[db][2] * inv, o[db][3] * inv); *(GAS u32x2*)(op + db * 16) = w; }
}

__device__ __forceinline__ void pool_task(int task, const bf16_t* proj, const bf16_t* PWt, const float* pscale, bf16_t* mix, int lane) {
    const int gi = task & 3, tb = task >> 2;
    const int i = lane & 15, g = lane >> 4;
    const int t = tb * 16 + i, tin = t & (SEQ - 1), tbase = t - tin;
    const int w = 2 << gi, half = w >> 1;
    const int lo = max(tin - half, 0), hi = min(tin + half, SEQ);
    const float rc = 1.0f / (float)(hi - lo);
    bf16x8 dB[2];
#pragma unroll
    for (int ks = 0; ks < 2; ++ks) {
        const bf16_t* cp = proj + C_CU + gi * 64 + ks * 32 + 8 * g;
        float s[8];
#pragma unroll
        for (int e = 0; e < 8; ++e) s[e] = 0.f;
#pragma unroll 2
        for (int k = 0; k < w; ++k) {
            const int rr = tin - half + k; const bool ok = (rr >= 0) && (rr < SEQ); const int rrc = min(max(rr, 0), SEQ - 1);
            const u32x4 v = *(const GAS u32x4*)(cp + (size_t)(tbase + rrc) * DIN);
            const float m = ok ? 1.f : 0.f;
            s[0] += m * bflo(v.x); s[1] += m * bfhi(v.x); s[2] += m * bflo(v.y); s[3] += m * bfhi(v.y);
            s[4] += m * bflo(v.z); s[5] += m * bfhi(v.z); s[6] += m * bflo(v.w); s[7] += m * bfhi(v.w);
        }
        const u32x4 me = *(const GAS u32x4*)(cp + (size_t)t * DIN);
        u32x4 dw;
        dw.x = pk2(s[0] * rc - bflo(me.x), s[1] * rc - bfhi(me.x)); dw.y = pk2(s[2] * rc - bflo(me.y), s[3] * rc - bfhi(me.y));
        dw.z = pk2(s[4] * rc - bflo(me.z), s[5] * rc - bfhi(me.z)); dw.w = pk2(s[6] * rc - bflo(me.w), s[7] * rc - bfhi(me.w));
        dB[ks] = __builtin_bit_cast(bf16x8, dw);
    }
    const bf16_t* pw = PWt + (size_t)gi * 64 * 64 + i * 64 + 8 * g;
    bf16_t* op = mix + (size_t)t * D + 768 + gi * 64 + 4 * g;
    const float* ps = pscale + gi * 64 + 4 * g;
#pragma unroll
    for (int nb = 0; nb < 4; ++nb) {
        const bf16x8 a0 = *(const GAS bf16x8*)(pw + nb * 16 * 64), a1 = *(const GAS bf16x8*)(pw + nb * 16 * 64 + 32);
        f32x4 acc = {0.f, 0.f, 0.f, 0.f};
        acc = mfma16(a0, dB[0], acc); acc = mfma16(a1, dB[1], acc);
        const f32x4 sv = *(const GAS f32x4*)(ps + nb * 16);
        u32x2 wv; wv.x = pk2(acc[0] * sv[0], acc[1] * sv[1]); wv.y = pk2(acc[2] * sv[2], acc[3] * sv[3]);
        *(GAS u32x2*)(op + nb * 16) = wv;
    }
}

__device__ __forceinline__ void router_task(int t0, const float* X, const bf16_t* WrH, const bf16_t* WrL, const float* rgb, const float* reb,
                                            LAS int* lcnt, LAS int* le, LAS int* lr, int slot0, float* tokg, int lane) {
    const int i = lane & 15, g = lane >> 4;
    const float* xp = X + (size_t)(t0 + i) * D + 8 * g;
    const bf16_t* wh = WrH + (size_t)i * D + 8 * g; const bf16_t* wl = WrL + (size_t)i * D + 8 * g;
    f32x4 acc[3];
#pragma unroll
    for (int nb = 0; nb < 3; ++nb) acc[nb] = (f32x4){0.f, 0.f, 0.f, 0.f};
    float ss = 0.f;
#pragma unroll 4
    for (int s = 0; s < 32; ++s) {
        const f32x4 xa = *(const GAS f32x4*)(xp + 32 * s), xb = *(const GAS f32x4*)(xp + 32 * s + 4);
        ss += (xa[0] * xa[0] + xa[1] * xa[1]) + (xa[2] * xa[2] + xa[3] * xa[3]) + (xb[0] * xb[0] + xb[1] * xb[1]) + (xb[2] * xb[2] + xb[3] * xb[3]);
        u32x4 hw; hw.x = pk2(xa[0], xa[1]); hw.y = pk2(xa[2], xa[3]); hw.z = pk2(xb[0], xb[1]); hw.w = pk2(xb[2], xb[3]);
        u32x4 lw; lw.x = pk2(xa[0] - bflo(hw.x), xa[1] - bfhi(hw.x)); lw.y = pk2(xa[2] - bflo(hw.y), xa[3] - bfhi(hw.y));
        lw.z = pk2(xb[0] - bflo(hw.z), xb[1] - bfhi(hw.z)); lw.w = pk2(xb[2] - bflo(hw.w), xb[3] - bfhi(hw.w));
        const bf16x8 xh = __builtin_bit_cast(bf16x8, hw), xl = __builtin_bit_cast(bf16x8, lw);
#pragma unroll
        for (int nb = 0; nb < 3; ++nb) {
            const bf16x8 ah = *(const GAS bf16x8*)(wh + (size_t)nb * 16 * D + 32 * s), al = *(const GAS bf16x8*)(wl + (size_t)nb * 16 * D + 32 * s);
            acc[nb] = mfma16(ah, xh, acc[nb]); acc[nb] = mfma16(ah, xl, acc[nb]); acc[nb] = mfma16(al, xh, acc[nb]);
        }
    }
    ss += __shfl_xor(ss, 16); ss += __shfl_xor(ss, 32);
    const float rstd = 1.0f / sqrtf(ss * (1.0f / D) + RMS_EPS);
    float gl[4]; float gm = -1e30f;
#pragma unroll
    for (int k = 0; k < 4; ++k) { gl[k] = acc[0][k] * rstd + rgb[k]; gm = fmaxf(gm, gl[k]); }
    int gt = 0; float gs = 0.f;
#pragma unroll
    for (int k = 3; k >= 0; --k) { if (gl[k] == gm) gt = k; gs += expf(gl[k] - gm); }
    const float gtp = 1.0f / gs;
    if (g == gt) {
        float el[8]; float em = -1e30f;
#pragma unroll
        for (int k = 0; k < 8; ++k) { el[k] = ((k < 4) ? acc[1][k & 3] : acc[2][k & 3]) * rstd + reb[8 * g + k]; em = fmaxf(em, el[k]); }
        int i0 = 0;
#pragma unroll
        for (int k = 7; k >= 0; --k) if (el[k] == em) i0 = k;
        float e2 = -1e30f;
#pragma unroll
        for (int k = 0; k < 8; ++k) if (k != i0) e2 = fmaxf(e2, el[k]);
        int i1 = 0;
#pragma unroll
        for (int k = 7; k >= 0; --k) if (k != i0 && el[k] == e2) i1 = k;
        const float p1 = expf(e2 - em);
        const float g0 = gtp / (1.0f + p1), g1 = gtp * p1 / (1.0f + p1);
        const int ea = 8 * g + i0, eb = 8 * g + i1;
        const int ra = __hip_atomic_fetch_add((int*)(lcnt + ea), 1, __ATOMIC_RELAXED, __HIP_MEMORY_SCOPE_WORKGROUP);
        const int rb = __hip_atomic_fetch_add((int*)(lcnt + eb), 1, __ATOMIC_RELAXED, __HIP_MEMORY_SCOPE_WORKGROUP);
        le[2 * (slot0 + i)] = ea; le[2 * (slot0 + i) + 1] = eb; lr[2 * (slot0 + i)] = ra; lr[2 * (slot0 + i) + 1] = rb;
        tokg[2 * (size_t)(t0 + i)] = g0; tokg[2 * (size_t)(t0 + i) + 1] = g1;
    }
}

__global__ void __launch_bounds__(NTHR, 2) hybrid_fwd(Args args) {
    extern __shared__ __attribute__((aligned(16))) unsigned char lds_raw[];
    LAS unsigned char* lds = (LAS unsigned char*)lds_raw;
    const int tid = threadIdx.x, lane = tid & 63, wave = __builtin_amdgcn_readfirstlane(tid >> 6);
    const int G = gridDim.x, bx = blockIdx.x;
    const int vcu = (G % 8 == 0) ? (bx % 8) * (G / 8) + bx / 8 : bx;
    const int gw = vcu * NWAVES + wave, NGW = G * NWAVES;
    for (int u = tid; u < (LDS_BYTES - LDSCTL_OFF) / 4; u += NTHR) ((LAS unsigned*)(lds + LDSCTL_OFF))[u] = 0u;
    __syncthreads();
    if (tid == 0) {
        LAS unsigned long long* ap = (LAS unsigned long long*)(lds + ARGS_OFF);
#pragma unroll
        for (int k = 0; k < 17; ++k) ap[k] = (unsigned long long)args.in[k];
        ap[17] = (unsigned long long)args.out; ap[18] = (unsigned long long)args.ws;
    }
    __syncthreads();
    volatile LAS unsigned* MISC = (volatile LAS unsigned*)(lds + MISC_OFF);
    XcdBarrier bar = xcd_barrier_post((unsigned*)(WSP() + WS_CTL) + CW_BAR, MISC + 8);
#define GRID_BAR() xcd_barrier(bar)
    LAS int* s_off = (LAS int*)(lds + SCHED_OFF); LAS int* s_tpre = s_off + 40;

    p0_prologue(lds, gw, NGW, wave, launder_v(lane));
    GRID_BAR();

#pragma unroll 1
    for (int l = 0; l < DEPTH; ++l) {
        {
            unsigned char* ws = WSP();
            pg8::Gemm g{(const bf16_t*)(ws + WS_H), (const bf16_t*)(ws + WS_W + (size_t)l * W_LAYER + W_IN), launder_i(D)}; pg8::StaticOrder S; S.init(T, DIN, G, bx);
            pg8::EpiProj E{(bf16_t*)(ws + WS_PROJ), (bf16_t*)(ws + WS_VTA), (bf16_t*)(ws + WS_VTB)};
            pg8::gemm_phase<pg8::EpiProj, pg8::StaticOrder, true, true>(lds, g, S, E);
        }
        GRID_BAR();
        {
            const int tid = launder_v((int)threadIdx.x), lane = tid & 63;
            unsigned char* ws = WSP();
            const bf16_t* PROJ = (const bf16_t*)(ws + WS_PROJ); bf16_t* MIX = (bf16_t*)(ws + WS_MIX);
            { const bf16_t* VTB = (const bf16_t*)(ws + WS_VTB); const float* sk = ARGF(I_SINK) + l * 8;
              for (int task = gw; task < 8192; task += NGW) swa_task(task, PROJ, VTB, sk, MIX, lane); }
            { const bf16_t* VTA = (const bf16_t*)(ws + WS_VTA); const float* nb = ARGF(I_NATB) + (size_t)l * 4 * 15 * 31;
              for (int task = gw; task < 4096; task += NGW) na_task(task, PROJ, VTA, nb, MIX, lane); }
            { const bf16_t* PW = (const bf16_t*)(ws + WS_PW) + (size_t)l * 4 * 64 * 64; const float* ps = ARGF(I_POOLS) + l * 256;
              for (int task = gw; task < 4096; task += NGW) pool_task(task, PROJ, PW, ps, MIX, lane); }
        }
        GRID_BAR();
        {
            unsigned char* ws = WSP(); float* X = (float*)arg_u64(lds, 17);
            pg8::Gemm g{(const bf16_t*)(ws + WS_MIX), (const bf16_t*)(ws + WS_W + (size_t)l * W_LAYER + W_OUT), launder_i(D)}; pg8::StaticOrder S; S.init(T, D, G, bx);
            pg8::EpiResid E{l == 0 ? ARGF(I_X) : (const float*)X, X};
            pg8::gemm_phase<pg8::EpiResid, pg8::StaticOrder, true, true>(lds, g, S, E);
        }
        GRID_BAR();
        {
            const int tid = launder_v((int)threadIdx.x), lane = tid & 63;
            unsigned char* ws = WSP(); const float* X = (const float*)arg_u64(lds, 17);
            LAS int* lcnt = (LAS int*)lds; LAS int* lbase = lcnt + 32; LAS int* le = lcnt + 64; LAS int* lr = le + 128;
            gu32* gcnt = (gu32*)(ws + WS_CTL) + CW_CNT + l * 64;
            int* TOKE = (int*)(ws + WS_TOKE); float* TOKG = (float*)(ws + WS_TOKG); int* TOKR = (int*)(ws + WS_TOKR);
            for (int bt = vcu; bt < T / 64; bt += G) {
                if (tid < 32) lcnt[tid] = 0;
                __syncthreads();
                if (wave < 4) router_task(bt * 64 + wave * 16, X, (const bf16_t*)(ws + WS_WRH) + (size_t)l * 48 * D, (const bf16_t*)(ws + WS_WRL) + (size_t)l * 48 * D,
                                          ARGF(I_RGB) + l * 4, ARGF(I_REB) + l * NE, lcnt, le, lr, wave * 16, TOKG, lane);
                __syncthreads();
                if (tid < 32) lbase[tid] = (int)__hip_atomic_fetch_add(gcnt + tid, (unsigned)lcnt[tid], RLX_AGENT);
                __syncthreads();
                if (tid < 128) { const int e = le[tid]; TOKE[(size_t)bt * 128 + tid] = e; TOKR[(size_t)bt * 128 + tid] = lbase[e] + lr[tid]; }
                __syncthreads();
            }
        }
        GRID_BAR();
        {
            const int tid = launder_v((int)threadIdx.x), lane = tid & 63;
            unsigned char* ws = WSP(); const float* X = (const float*)arg_u64(lds, 17);
            gu32* gcnt = (gu32*)(ws + WS_CTL) + CW_CNT + l * 64;
            if (tid == 0) { int o = 0, tp = 0;
                for (int e = 0; e < NE; ++e) { const int c = (int)__hip_atomic_load(gcnt + e, RLX_AGENT); s_off[e] = o; s_tpre[e] = tp; o += c; tp += (c + 255) >> 8; }
                s_off[NE] = o; s_tpre[NE] = tp; }
            __syncthreads();
            const float* g2 = ARGF(I_N2G) + l * D;
            gu32* TOKE = (gu32*)(ws + WS_TOKE); gu32* TOKR = (gu32*)(ws + WS_TOKR); bf16_t* HS = (bf16_t*)(ws + WS_HS);
            for (int t = gw; t < T; t += NGW) {
                const int e0 = (int)__hip_atomic_load(TOKE + 2 * t, RLX_AGENT), e1 = (int)__hip_atomic_load(TOKE + 2 * t + 1, RLX_AGENT);
                const int r0 = (int)__hip_atomic_load(TOKR + 2 * t, RLX_AGENT), r1 = (int)__hip_atomic_load(TOKR + 2 * t + 1, RLX_AGENT);
                const int p0 = s_off[e0] + r0, p1 = s_off[e1] + r1;
                norm_row_bf16(X + (size_t)t * D, g2, HS + (size_t)p0 * D, lane);
                norm_row_bf16(X + (size_t)t * D, g2, HS + (size_t)p1 * D, lane);
                VM_WAIT();
                if (lane == 0) { __hip_atomic_store(TOKR + 2 * t, (unsigned)p0, RLX_AGENT); __hip_atomic_store(TOKR + 2 * t + 1, (unsigned)p1, RLX_AGENT); }
            }
        }
        GRID_BAR();
        {
            unsigned char* ws = WSP();
            pg8::Gemm g{(const bf16_t*)(ws + WS_HS), (const bf16_t*)(ws + WS_W + (size_t)l * W_LAYER + W_GU), launder_i(D)};
            pg8::GroupedOrder S{s_off, s_tpre, 1, 512, G, vcu};
            pg8::EpiAct E{(bf16_t*)(ws + WS_ACT)};
            pg8::gemm_phase<pg8::EpiAct, pg8::GroupedOrder, true, true>(lds, g, S, E);
        }
        GRID_BAR();
        {
            unsigned char* ws = WSP();
            pg8::Gemm g{(const bf16_t*)(ws + WS_ACT), (const bf16_t*)(ws + WS_W + (size_t)l * W_LAYER + W_DN), launder_i(DE)};
            pg8::GroupedOrder S{s_off, s_tpre, 2, 1024, G, vcu};
            pg8::EpiY E{(bf16_t*)(ws + WS_HS)};
            pg8::gemm_phase<pg8::EpiY, pg8::GroupedOrder, true, true>(lds, g, S, E);
        }
        GRID_BAR();
        {
            const int tid = launder_v((int)threadIdx.x), lane = tid & 63;
            unsigned char* ws = WSP(); float* X = (float*)arg_u64(lds, 17);
            const float* gn = (l + 1 < DEPTH) ? ARGF(I_N1G) + (l + 1) * D : ARGF(I_FG);
            gu32* TOKR = (gu32*)(ws + WS_TOKR); gu32* TOKG = (gu32*)(ws + WS_TOKG); const bf16_t* HS = (const bf16_t*)(ws + WS_HS); bf16_t* H = (bf16_t*)(ws + WS_H);
            for (int t = gw; t < T; t += NGW) {
                const int p0 = (int)__hip_atomic_load(TOKR + 2 * t, RLX_AGENT), p1 = (int)__hip_atomic_load(TOKR + 2 * t + 1, RLX_AGENT);
                const float g0 = __uint_as_float(__hip_atomic_load(TOKG + 2 * t, RLX_AGENT)), g1 = __uint_as_float(__hip_atomic_load(TOKG + 2 * t + 1, RLX_AGENT));
                const GAS f32x4* xr = (const GAS f32x4*)(X + (size_t)t * D) + lane;
                const GAS u32x2* y0 = (const GAS u32x2*)(HS + (size_t)p0 * D) + lane; const GAS u32x2* y1 = (const GAS u32x2*)(HS + (size_t)p1 * D) + lane;
                f32x4 v[4]; float s = 0.f;
#pragma unroll
                for (int j = 0; j < 4; ++j) { const f32x4 x = xr[64 * j]; const u32x2 a = y0[64 * j], b = y1[64 * j];
                    v[j].x = x.x + g0 * bflo(a.x) + g1 * bflo(b.x); v[j].y = x.y + g0 * bfhi(a.x) + g1 * bfhi(b.x);
                    v[j].z = x.z + g0 * bflo(a.y) + g1 * bflo(b.y); v[j].w = x.w + g0 * bfhi(a.y) + g1 * bfhi(b.y);
                    s += (v[j].x * v[j].x + v[j].y * v[j].y) + (v[j].z * v[j].z + v[j].w * v[j].w); }
                const float rstd = 1.0f / sqrtf(wave_sum(s) * (1.0f / D) + RMS_EPS);
                const GAS f32x4* gr = (const GAS f32x4*)gn + lane;
                GAS f32x4* xo = (GAS f32x4*)(X + (size_t)t * D) + lane;
                if (l + 1 < DEPTH) {
                    GAS u32x2* ho = (GAS u32x2*)(H + (size_t)t * D) + lane;
#pragma unroll
                    for (int j = 0; j < 4; ++j) { const f32x4 gg = gr[64 * j]; xo[64 * j] = v[j];
                        u32x2 w; w.x = pk2(v[j].x * rstd * gg.x, v[j].y * rstd * gg.y); w.y = pk2(v[j].z * rstd * gg.z, v[j].w * rstd * gg.w); ho[64 * j] = w; }
                } else {
#pragma unroll
                    for (int j = 0; j < 4; ++j) { const f32x4 gg = gr[64 * j]; xo[64 * j] = (f32x4){v[j].x * rstd * gg.x, v[j].y * rstd * gg.y, v[j].z * rstd * gg.z, v[j].w * rstd * gg.w}; }
                }
            }
        }
        if (l + 1 < DEPTH) GRID_BAR();
    }
}

extern "C" void kernel_launch(void* const* d_in, const int* in_sizes, int n_in, void* d_out, int out_size, void* d_ws, size_t ws_size, hipStream_t stream) {
    static int grid = 0;
    if (grid == 0) {
        if (n_in != 17 || out_size != T * D || ws_size < WS_END) { fprintf(stderr, "kernel_launch: unexpected shapes (n_in %d out %d ws %zu)\n", n_in, out_size, ws_size); grid = -1; return; }
        int dev = 0, cus = 0, per_cu = 0;
        if (hipGetDevice(&dev) != hipSuccess || hipDeviceGetAttribute(&cus, hipDeviceAttributeMultiprocessorCount, dev) != hipSuccess) { grid = -1; return; }
        if (hipFuncSetAttribute((const void*)hybrid_fwd, hipFuncAttributeMaxDynamicSharedMemorySize, LDS_BYTES) != hipSuccess) { fprintf(stderr, "kernel_launch: hipFuncSetAttribute failed\n"); grid = -1; return; }
        if (hipOccupancyMaxActiveBlocksPerMultiprocessor(&per_cu, (const void*)hybrid_fwd, NTHR, LDS_BYTES) != hipSuccess || per_cu < 1) { fprintf(stderr, "kernel_launch: occupancy query says %d\n", per_cu); (void)hipGetLastError(); grid = -1; return; }
        grid = cus;
    }
    if (grid < 0) return;
    if (hipMemsetAsync((char*)d_ws + WS_CTL, 0, CTL_ZERO_BYTES, stream) != hipSuccess) { fprintf(stderr, "kernel_launch: memset failed\n"); return; }
    Args a{};
    for (int i = 0; i < 17; ++i) a.in[i] = (const float*)d_in[i];
    a.out = (float*)d_out; a.ws = (unsigned char*)d_ws;
    void* kargs[] = {&a};
    const hipError_t e = hipLaunchCooperativeKernel((const void*)hybrid_fwd, dim3(grid), dim3(NTHR), kargs, LDS_BYTES, stream);
    if (e != hipSuccess) fprintf(stderr, "kernel_launch: cooperative launch failed: %s (grid %d)\n", hipGetErrorString(e), grid);
}
```

```cpp
#include <hip/hip_runtime.h>
#include <cstdio>
#include <cstdint>
#define PROBE_MULT 4

__device__ __forceinline__ int launder_v(int v) { asm volatile("" : "+v"(v)); return v; }
namespace pg8 {
#define PG8_LAS __attribute__((address_space(3)))
typedef __attribute__((address_space(3))) int LAS_I;
typedef unsigned short bf16_t;
typedef short bf16x8 __attribute__((ext_vector_type(8)));
typedef float f32x4 __attribute__((ext_vector_type(4)));
typedef unsigned u32x4 __attribute__((ext_vector_type(4)));
typedef unsigned u32x2 __attribute__((ext_vector_type(2)));
constexpr int T_ROWS = 16384;
constexpr int BM = 256, BK = 64, HALF = 128, HTB = HALF * BK * 2  , STAGE_BYTES = 8 * HTB, NXCD = 8, WGM = 8;

__host__ __device__ __forceinline__ int lds_byte(int r, int c) { const int st = (r >> 4) * 2 + (c >> 5), rr = r & 15, cc = c & 31, ob = rr * 64 + cc * 2; return st * 1024 + (ob ^ (((ob >> 9) & 1) << 5)); }
__host__ __device__ __forceinline__ void stage_rc(int b, int& R, int& C) { const int st = b / 1024, sb = b % 1024, swz = sb ^ (((sb >> 9) & 1) << 5); R = (st >> 1) * 16 + swz / 64; C = (st & 1) * 32 + (swz % 64) / 2; }
__host__ __device__ __forceinline__ int perm32(int rho) { const int n = rho >> 4, i = rho & 15; return 8 * (i >> 2) + 4 * n + (i & 3); }

struct Unit { int arow, aend, brow, orow, ocol, rlim; };
struct Gemm { const bf16_t* A; const bf16_t* Bt; int K; };

struct StaticOrder {
    int nM, nN, nwg, G, c; const LAS_I* tokl = nullptr;
    __host__ __device__ void init(int M, int N, int G_, int c_) { nM = M / BM; nN = N / BM; nwg = nM * nN; G = G_; c = c_; }
    __host__ __device__ bool next(int i, Unit& u) const {
        const long L = (long)i * G + c; if (L >= nwg) return false;
        int wgid = (int)L; { const int q = nwg / NXCD, r = nwg % NXCD, xcd = wgid % NXCD, off = wgid / NXCD; wgid = (xcd < r ? xcd * (q + 1) : r * (q + 1) + (xcd - r) * q) + off; }
        const int nig = WGM * nN, gid = wgid / nig, fm = gid * WGM, gsz = (nM - fm) < WGM ? (nM - fm) : WGM;
        const int pm = fm + ((wgid % nig) % gsz), pn = (wgid % nig) / gsz;
        u.arow = pm * BM; u.aend = 0; u.orow = pm * BM; u.brow = pn * BM; u.ocol = pn * BM; u.rlim = 0x7fffffff; return true;
    }
    __device__ __forceinline__ void a_ready(const Unit&, int) const {}
    __device__ __forceinline__ void done(const Unit&) const {}
};

template <class Epi, class Sched, bool ALIGN_EPI = false, bool SP2 = false, bool GATHER = false>
__device__ __forceinline__ void gemm_phase(PG8_LAS unsigned char* lds, const Gemm g, const Sched& S, const Epi& E) {
    const int tid = launder_v((int)threadIdx.x), wid = __builtin_amdgcn_readfirstlane(tid >> 6), lane = tid & 63, wr = wid >> 2, wc = wid & 3, fr = lane & 15, fq = lane >> 4;
    const int K = g.K, nt = K / BK;
    unsigned voffA[2], voffB[2];
#pragma unroll
    for (int i = 0; i < 2; ++i) { int R, C; stage_rc(tid * 16 + i * 8192, R, C); const int Rb = Epi::PERM ? ((R & ~31) + perm32(R & 31)) : R;
        voffA[i] = (unsigned)(R * K + C) * 2u; voffB[i] = (unsigned)(Rb * K + C) * 2u;
    }
    if (GATHER) { int R, C; stage_rc(tid * 16, R, C); voffA[0] = (unsigned)C * 2u; voffA[1] = (unsigned)R * 4u; }
    static_assert(!GATHER || SP2, "row gather is implemented for the SP2 loop only");
    const size_t kstep = (size_t)(BK * 2);
    const size_t hstep = (size_t)HALF * K * 2;
    const size_t rowb = (size_t)K * 2;
    const unsigned ldsw = (unsigned)wid * 1024u;
    const int aoff = lds_byte(wr * 64 + fr, fq * 8), boff = lds_byte(wc * 32 + fr, fq * 8);
#define PG8_SA(b, h) (((b) * 2 + (h)) * HTB)
#define PG8_SB(b, h) ((4 + (b) * 2 + (h)) * HTB)
#define PG8_STAGE(bufoff, gbase, voff) do { _Pragma("unroll") for (int _i = 0; _i < 2; ++_i) \
        __builtin_amdgcn_global_load_lds((const unsigned*)((const char*)(gbase) + (voff)[_i]), (PG8_LAS unsigned*)(lds + (bufoff) + ldsw + _i * 8192), 16, 0, 0); } while (0)
#define PG8_STAGEA(bufoff, gbase, h, slot) do { if constexpr (GATHER) { _Pragma("unroll") for (int _i = 0; _i < 2; ++_i) { \
        const unsigned _row = *(const PG8_LAS unsigned*)((const PG8_LAS unsigned char*)S.tokl + voffA[1] + (unsigned)(slot) * 1024u + (h) * 512 + _i * 256); \
        __builtin_amdgcn_global_load_lds((const unsigned*)((const char*)(gbase) + (size_t)(_row * (unsigned)rowb + voffA[0])), (PG8_LAS unsigned*)(lds + (bufoff) + ldsw + _i * 8192), 16, 0, 0); } } \
    else { PG8_STAGE(bufoff, (const char*)(gbase) + (h) * hstep, voffA); } } while (0)
#define PG8_LDA(dst, b, h) do { _Pragma("unroll") for (int m = 0; m < 4; ++m) _Pragma("unroll") for (int k = 0; k < 2; ++k) dst[m][k] = *(const PG8_LAS bf16x8*)(lds + PG8_SA(b, h) + aoff + m * 2048 + k * 1024); } while (0)
#define PG8_LDB(dst, b, h) do { _Pragma("unroll") for (int n = 0; n < 2; ++n) _Pragma("unroll") for (int k = 0; k < 2; ++k) dst[n][k] = *(const PG8_LAS bf16x8*)(lds + PG8_SB(b, h) + boff + n * 2048 + k * 1024); } while (0)
#define PG8_MMA(ai, bj, At, Bt) do { __builtin_amdgcn_s_setprio(1); _Pragma("unroll") for (int m = 0; m < 4; ++m) _Pragma("unroll") for (int n = 0; n < 2; ++n) _Pragma("unroll") for (int k = 0; k < 2; ++k) \
        acc[ai][bj][m][n] = __builtin_amdgcn_mfma_f32_16x16x32_bf16(Bt[n][k], At[m][k], acc[ai][bj][m][n], 0, 0, 0); __builtin_amdgcn_s_setprio(0); } while (0)
#define PG8_WAIT_V(n) asm volatile("s_waitcnt vmcnt(" #n ")" ::: "memory")
#define PG8_WAIT_L(n) asm volatile("s_waitcnt lgkmcnt(" #n ")" ::: "memory")
#define PG8_BAR __builtin_amdgcn_s_barrier()
#define PG8_SCHED __builtin_amdgcn_sched_barrier(0)
    Unit cur, nxt; int ui = 0;
    if (!S.next(0, cur)) return;
    f32x4 acc[2][2][4][2];
#pragma unroll
    for (int a = 0; a < 2; ++a)
#pragma unroll
        for (int b = 0; b < 2; ++b)
#pragma unroll
            for (int m = 0; m < 4; ++m)
#pragma unroll
                for (int n = 0; n < 2; ++n) acc[a][b][m][n] = (f32x4){0.f, 0.f, 0.f, 0.f};
    bf16x8 At[4][2], B0[2][2], B1[2][2];
    const char* cA = (const char*)g.A + (GATHER ? (size_t)0 : (size_t)cur.arow * rowb); const char* cB = (const char*)g.Bt + (size_t)cur.brow * rowb;
    int cs = 0;
    S.a_ready(cur, 0);
    if constexpr (SP2) {
        PG8_STAGE(PG8_SB(0, 0), cB, voffB); PG8_STAGE(PG8_SB(0, 1), cB + hstep, voffB); PG8_STAGEA(PG8_SA(0, 0), cA, 0, cs); PG8_STAGEA(PG8_SA(0, 1), cA, 1, cs);
        if (wr == 1) PG8_BAR;
        PG8_WAIT_V(2); PG8_BAR;
        PG8_STAGE(PG8_SB(1, 0), cB + kstep, voffB); PG8_STAGEA(PG8_SA(1, 0), cA + kstep, 0, cs); PG8_STAGE(PG8_SB(1, 1), cB + hstep + kstep, voffB);
        PG8_WAIT_V(6); PG8_BAR;
    } else {
        PG8_STAGE(PG8_SB(0, 0), cB, voffB); PG8_STAGE(PG8_SA(0, 0), cA, voffA); PG8_STAGE(PG8_SB(0, 1), cB + hstep, voffB); PG8_STAGE(PG8_SA(0, 1), cA + hstep, voffA);
        if (wr == 1) PG8_BAR;
        PG8_WAIT_V(4); PG8_BAR;
        PG8_STAGE(PG8_SB(1, 0), cB + kstep, voffB); PG8_STAGEA(PG8_SA(1, 0), cA + kstep, 0, cs); PG8_STAGE(PG8_SB(1, 1), cB + hstep + kstep, voffB);
        PG8_WAIT_V(6); PG8_BAR;
    }
    for (;;) {
        const bool has_next = S.next(ui + 1, nxt);
        const char* nA = (has_next && !GATHER) ? (const char*)g.A + (size_t)nxt.arow * rowb : cA; const char* nB = has_next ? (const char*)g.Bt + (size_t)nxt.brow * rowb : cB;
        for (int t = 0; t < nt; t += 2) {
            const bool last = (t == nt - 2);
            const char* a1 = cA + (size_t)(t + 1) * kstep;
            const char* a2 = last ? nA : cA + (size_t)(t + 2) * kstep; const char* b2 = last ? nB : cB + (size_t)(t + 2) * kstep;
            const char* a3 = a2 + kstep; const char* b3 = b2 + kstep;
            if (last && has_next) S.a_ready(nxt, cs ^ 1);
            const int ns2 = (last && has_next) ? (cs ^ 1) : cs;
            if constexpr (SP2) {
            PG8_LDB(B0, 0, 0); PG8_LDB(B1, 0, 1); PG8_SCHED; PG8_LDA(At, 0, 0); PG8_STAGEA(PG8_SA(1, 1), a1, 1, cs);
            PG8_WAIT_V(8); PG8_WAIT_L(0); PG8_BAR; PG8_MMA(0, 0, At, B0); PG8_MMA(0, 1, At, B1); PG8_BAR; PG8_SCHED;
            PG8_LDA(At, 0, 1); PG8_STAGE(PG8_SB(0, 0), b2, voffB); PG8_STAGE(PG8_SB(0, 1), b2 + hstep, voffB); PG8_STAGEA(PG8_SA(0, 0), a2, 0, ns2);
            PG8_WAIT_V(8); PG8_WAIT_L(0); PG8_BAR; PG8_MMA(1, 0, At, B0); PG8_MMA(1, 1, At, B1); PG8_BAR; PG8_SCHED;
            PG8_LDB(B0, 1, 0); PG8_LDB(B1, 1, 1); PG8_SCHED; PG8_LDA(At, 1, 0); PG8_STAGEA(PG8_SA(0, 1), a2, 1, ns2);
            PG8_WAIT_V(8); PG8_WAIT_L(0); PG8_BAR; PG8_MMA(0, 0, At, B0); PG8_MMA(0, 1, At, B1); PG8_BAR; PG8_SCHED;
            PG8_LDA(At, 1, 1); PG8_STAGE(PG8_SB(1, 0), b3, voffB); PG8_STAGE(PG8_SB(1, 1), b3 + hstep, voffB); PG8_STAGEA(PG8_SA(1, 0), a3, 0, ns2);
            PG8_WAIT_V(8); PG8_WAIT_L(0); PG8_BAR; PG8_MMA(1, 0, At, B0); PG8_MMA(1, 1, At, B1); PG8_BAR; PG8_SCHED;
            } else {
            PG8_LDB(B0, 0, 0); PG8_SCHED; PG8_LDA(At, 0, 0); PG8_STAGE(PG8_SA(1, 1), a1 + hstep, voffA);
            PG8_WAIT_L(8); PG8_BAR; PG8_WAIT_L(0); PG8_MMA(0, 0, At, B0); PG8_BAR; PG8_SCHED;
            PG8_LDB(B1, 0, 1); PG8_STAGE(PG8_SB(0, 0), b2, voffB);
            PG8_BAR; PG8_WAIT_L(0); PG8_MMA(0, 1, At, B1); PG8_BAR;
            PG8_LDA(At, 0, 1); PG8_STAGE(PG8_SA(0, 0), a2, voffA);
            PG8_BAR; PG8_WAIT_L(0); PG8_MMA(1, 0, At, B0); PG8_BAR; PG8_SCHED;
            PG8_STAGE(PG8_SB(0, 1), b2 + hstep, voffB);
            PG8_WAIT_V(6); PG8_BAR; PG8_MMA(1, 1, At, B1); PG8_BAR;
            PG8_LDB(B0, 1, 0); PG8_SCHED; PG8_LDA(At, 1, 0); PG8_STAGE(PG8_SA(0, 1), a2 + hstep, voffA);
            PG8_WAIT_L(8); PG8_BAR; PG8_WAIT_L(0); PG8_MMA(0, 0, At, B0); PG8_BAR; PG8_SCHED;
            PG8_LDB(B1, 1, 1); PG8_STAGE(PG8_SB(1, 0), b3, voffB);
            PG8_BAR; PG8_WAIT_L(0); PG8_MMA(0, 1, At, B1); PG8_BAR;
            PG8_LDA(At, 1, 1); PG8_STAGE(PG8_SA(1, 0), a3, voffA);
            PG8_BAR; PG8_WAIT_L(0); PG8_MMA(1, 0, At, B0); PG8_BAR; PG8_SCHED;
            PG8_STAGE(PG8_SB(1, 1), b3 + hstep, voffB);
            PG8_WAIT_V(6); PG8_BAR; PG8_MMA(1, 1, At, B1); PG8_BAR;
            }
        }
        if constexpr (ALIGN_EPI) { if (wr == 0) PG8_BAR; }
        if constexpr (!Epi::AFTER_DRAIN) { E(acc, cur, wr, wc, fr, fq); S.done(cur); }
        if (!has_next) break;
#pragma unroll
        for (int a = 0; a < 2; ++a)
#pragma unroll
            for (int b = 0; b < 2; ++b)
#pragma unroll
                for (int m = 0; m < 4; ++m)
#pragma unroll
                    for (int n = 0; n < 2; ++n) acc[a][b][m][n] = (f32x4){0.f, 0.f, 0.f, 0.f};
        cur = nxt; cA = nA; cB = nB; ++ui; cs ^= 1;
        if constexpr (ALIGN_EPI) { if (wr == 1) PG8_BAR; }
    }
    PG8_WAIT_V(0);
    if constexpr (!ALIGN_EPI) { if (wr == 0) PG8_BAR; }
    PG8_BAR;
    if constexpr (Epi::AFTER_DRAIN) { E.fused(acc, cur, wr, wc, fr, fq, lds, wid, lane); S.done(cur); }
#undef PG8_SA
#undef PG8_SB
#undef PG8_STAGE
#undef PG8_STAGEA
#undef PG8_LDA
#undef PG8_LDB
#undef PG8_MMA
#undef PG8_WAIT_V
#undef PG8_WAIT_L
#undef PG8_BAR
#undef PG8_SCHED
}
}

using pg8::bf16_t; using pg8::bf16x8; using pg8::f32x4; using pg8::u32x4; using pg8::u32x2;
#define GAS __attribute__((address_space(1)))
#define LAS __attribute__((address_space(3)))
typedef GAS unsigned gu32;
#define RLX_AGENT __ATOMIC_RELAXED, __HIP_MEMORY_SCOPE_AGENT
#define LDS_WAIT() asm volatile("s_waitcnt lgkmcnt(0)" ::: "memory")
#define VM_WAIT() asm volatile("s_waitcnt vmcnt(0)" ::: "memory")

constexpr int NWAVES = 8, NTHR = 512;
constexpr int BATCH = 2, SEQ = 8192, T = BATCH * SEQ, D = 1024, DIN = 1792, NE = 32, DE = 256, DEPTH = 2;
constexpr float RMS_EPS = 1e-6f;
constexpr int C_AQ = 0, C_AK = 256, C_AV = 512, C_BQ = 768, C_BK = 1280, C_BV = 1408, C_CU = 1536;
constexpr int NROWS2 = 2 * T + 256;

constexpr size_t MiB = 1u << 20;
constexpr size_t WS_CTL = 0, CTL_ZERO_BYTES = 1 * MiB;
constexpr size_t WS_WRH = 1 * MiB;
constexpr size_t WS_WRL = WS_WRH + 2 * 48 * 1024 * 2;
constexpr size_t WS_PW = WS_WRL + 2 * 48 * 1024 * 2;
constexpr size_t WS_TOKE = 2 * MiB;
constexpr size_t WS_TOKG = WS_TOKE + (size_t)T * 8;
constexpr size_t WS_TOKR = WS_TOKG + (size_t)T * 8;
constexpr size_t WS_W = 4 * MiB, W_LAYER = 54 * MiB;
constexpr size_t W_IN = 0, W_OUT = (size_t)DIN * D * 2, W_GU = W_OUT + (size_t)D * D * 2, W_DN = W_GU + (size_t)NE * 512 * D * 2, W_END = W_DN + (size_t)NE * D * DE * 2;
static_assert(W_END <= W_LAYER, "weights");
constexpr size_t WS_H = 112 * MiB;
constexpr size_t WS_PROJ = 144 * MiB;
constexpr size_t WS_VTA = 200 * MiB;
constexpr size_t WS_VTB = 208 * MiB;
constexpr size_t WS_MIX = 212 * MiB;
constexpr size_t WS_HS = 144 * MiB;
constexpr size_t WS_ACT = 212 * MiB;
constexpr size_t WS_LIST = 244 * MiB;
constexpr size_t WS_END = 246 * MiB;
static_assert(WS_W + 2 * W_LAYER <= WS_H && WS_H + (size_t)T * D * 2 <= WS_PROJ && WS_PROJ + (size_t)T * DIN * 2 <= WS_VTA, "ws map 1");
static_assert(WS_HS + (size_t)NROWS2 * D * 2 <= WS_ACT && WS_ACT + (size_t)NROWS2 * DE * 2 <= WS_END && WS_MIX + (size_t)T * D * 2 <= WS_END, "ws map 2");
constexpr int CW_BAR = 4096, CW_CNT = 8192;

constexpr int RING_BYTES = 131072, LDSCTL_OFF = RING_BYTES, MISC_OFF = LDSCTL_OFF + 320, SCHED_OFF = LDSCTL_OFF + 1024, LDS_BYTES = 147456;

__device__ __forceinline__ unsigned pk2(float lo, float hi) {
    typedef float f2 __attribute__((ext_vector_type(2))); typedef __bf16 b2 __attribute__((ext_vector_type(2)));
    f2 v = {lo, hi}; b2 b = __builtin_convertvector(v, b2); return __builtin_bit_cast(unsigned, b); }
__device__ __forceinline__ float bflo(unsigned w) { return __uint_as_float(w << 16); }
__device__ __forceinline__ float bfhi(unsigned w) { return __uint_as_float(w & 0xffff0000u); }
__device__ __forceinline__ float wave_sum(float v) {
#pragma unroll
    for (int o = 1; o < 64; o <<= 1) v += __shfl_xor(v, o);
    return v;
}
__device__ __forceinline__ int launder_i(int v) { asm volatile("" : "+s"(v)); return v; }
template <class P> __device__ __forceinline__ P* launder_p(P* p) { asm volatile("" : "+s"(p)); return p; }
constexpr int TOKL_OFF = LDSCTL_OFF + 4096;
constexpr int ARGS_OFF = LDSCTL_OFF + 2048;
__device__ __forceinline__ unsigned long long arg_u64(LAS unsigned char* lds, int k) {
    const LAS unsigned* p = (const LAS unsigned*)(lds + ARGS_OFF) + 2 * k;
    const unsigned lo = __builtin_amdgcn_readfirstlane(p[0]), hi = __builtin_amdgcn_readfirstlane(p[1]);
    return ((unsigned long long)hi << 32) | lo; }
#define ARGF(k) ((const float*)arg_u64(lds, (k)))
#define WSP() ((unsigned char*)arg_u64(lds, 18))
__device__ __forceinline__ f32x4 mfma16(bf16x8 a, bf16x8 b, f32x4 c) { return __builtin_amdgcn_mfma_f32_16x16x32_bf16(a, b, c, 0, 0, 0); }

#define XB_TMO      128
#define XB_XCNT(j)  (256  + 64 * (j))
#define XB_XSUB(j)  (1280 + 64 * (j))
#define XB_XGEN(j)  (2304 + 64 * (j))
#define XB_TOP      3328
#define XB_TOPGEN   3392
#define XCD_BAR_WORDS 3456
#define XB_SPIN_CAP (1u << 18)

__device__ __forceinline__ unsigned xb_ld(unsigned* p)              { return __hip_atomic_load(p, __ATOMIC_RELAXED, __HIP_MEMORY_SCOPE_AGENT); }
__device__ __forceinline__ unsigned xb_add(unsigned* p, unsigned v) { return __hip_atomic_fetch_add(p, v, __ATOMIC_RELAXED, __HIP_MEMORY_SCOPE_AGENT); }
__device__ __forceinline__ unsigned xb_xcc_id() { return (unsigned)__builtin_amdgcn_s_getreg((3 << 11) | 20) & 0xFu; }
#define XB_SPIN(cond, bar) do { unsigned _sp = 0; while (cond) { __builtin_amdgcn_s_sleep(1); \
    if ((++_sp & 255u) == 0u) { if (xb_ld(&(bar)[XB_TMO])) break; if (_sp > XB_SPIN_CAP) { atomicAdd(&(bar)[XB_TMO], 1u); break; } } } } while (0)

struct XcdBarrier {
    unsigned* bar; unsigned x;
    volatile LAS unsigned* st;
};

__device__ __forceinline__ XcdBarrier xcd_barrier_post(unsigned* bar, volatile LAS unsigned* st) {
    XcdBarrier b; b.bar = bar; b.x = xb_xcc_id(); b.st = st;
    if (threadIdx.x == 0) (void)xb_add(&bar[XB_XCNT(b.x)], 1u);
    return b;
}
__device__ __forceinline__ void xcd_barrier_complete(unsigned* bar, unsigned x, unsigned& nloc, unsigned& nx) {
    const unsigned G = gridDim.x * gridDim.y * gridDim.z;
    unsigned sum, cnt, mine, sp = 0u;
    for (;;) {
        sum = 0u; cnt = 0u;
#pragma unroll 1
        for (unsigned j = 0; j < 16; ++j) { const unsigned c = xb_ld(&bar[XB_XCNT(j)]); sum += c; cnt += (c > 0u) ? 1u : 0u; }
        mine = xb_ld(&bar[XB_XCNT(x)]);
        if (sum == G) break;
        __builtin_amdgcn_s_sleep(1);
        if ((++sp & 255u) == 0u) { if (xb_ld(&bar[XB_TMO])) break; if (sp > XB_SPIN_CAP) { atomicAdd(&bar[XB_TMO], 1u); break; } }
    }
    nloc = mine > 0u ? mine : 1u; nx = cnt > 0u ? cnt : 1u;
}

__device__ __forceinline__ void xcd_barrier(const XcdBarrier& b) {
    asm volatile("s_waitcnt vmcnt(0)" ::: "memory");
    __syncthreads();
    if (threadIdx.x == 0) {
        unsigned* bar = b.bar;
        __builtin_amdgcn_s_waitcnt(0);
        unsigned nloc = b.st[0], nx = b.st[1];
        if (nloc == 0u) { xcd_barrier_complete(bar, b.x, nloc, nx); b.st[0] = nloc; b.st[1] = nx; }
        const unsigned old = xb_add(&bar[XB_XSUB(b.x)], 1u);
        const unsigned gen = old / nloc;
        if (old + 1u == (gen + 1u) * nloc) {
            __builtin_amdgcn_fence(__ATOMIC_RELEASE, "agent");
            asm volatile("s_waitcnt vmcnt(0)" ::: "memory");
            const unsigned og = xb_add(&bar[XB_TOP], 1u);
            const unsigned tg = og / nx;
            if (og + 1u == (tg + 1u) * nx) xb_add(&bar[XB_TOPGEN], 1u);
            else XB_SPIN(xb_ld(&bar[XB_TOPGEN]) == tg, bar);
            __builtin_amdgcn_fence(__ATOMIC_ACQUIRE, "agent");
            xb_add(&bar[XB_XGEN(b.x)], 1u);
            asm volatile("s_waitcnt vmcnt(0)" ::: "memory");
        } else {
            XB_SPIN(xb_ld(&bar[XB_XGEN(b.x)]) == gen, bar);
            __builtin_amdgcn_fence(__ATOMIC_ACQUIRE, "agent");
            asm volatile("s_waitcnt vmcnt(0)" ::: "memory");
        }
    }
    __syncthreads();
}


namespace pg8 {
struct EpiProj {
    static constexpr bool PERM = true, AFTER_DRAIN = false;
    bf16_t* P; bf16_t* VTa; bf16_t* VTb;
    __device__ __forceinline__ void operator()(const f32x4 (&acc)[2][2][4][2], const Unit& u, int wr, int wc, int fr, int fq) const {
        const int row0 = u.orow + wr * 64 + fr;
#pragma unroll
        for (int bj = 0; bj < 2; ++bj) {
            const int cb = u.ocol + bj * HALF, blk = cb >> 7;
            const int col0 = cb + wc * 32 + 8 * fq;
            if (blk == 4 || blk == 5 || blk == 11) {
                bf16_t* vt; int cl, nh;
                if (blk == 11) { vt = VTb; cl = col0 - C_BV; nh = 2; } else { vt = VTa; cl = col0 - C_AV; nh = 4; }
                const int head = cl >> 6, d0 = cl & 63;
#pragma unroll
                for (int ai = 0; ai < 2; ++ai)
#pragma unroll
                    for (int m = 0; m < 4; ++m) {
                        const int r = row0 + ai * HALF + m * 16, b = r >> 13, t = r & (SEQ - 1);
                        GAS bf16_t* p = (GAS bf16_t*)(vt + ((size_t)((b * nh + head) * 64 + d0)) * SEQ + t);
#pragma unroll
                        for (int n = 0; n < 2; ++n) { const f32x4 v = acc[ai][bj][m][n]; const unsigned w0 = pk2(v[0], v[1]), w1 = pk2(v[2], v[3]);
                            p[(size_t)(4 * n + 0) * SEQ] = (bf16_t)(w0 & 0xffffu); p[(size_t)(4 * n + 1) * SEQ] = (bf16_t)(w0 >> 16);
                            p[(size_t)(4 * n + 2) * SEQ] = (bf16_t)(w1 & 0xffffu); p[(size_t)(4 * n + 3) * SEQ] = (bf16_t)(w1 >> 16); }
                    }
            } else {
                const float sc = (blk <= 1 || (blk >= 6 && blk <= 9)) ? 0.125f : 1.0f;
#pragma unroll
                for (int ai = 0; ai < 2; ++ai)
#pragma unroll
                    for (int m = 0; m < 4; ++m) {
                        bf16_t* rowp = P + (size_t)(row0 + ai * HALF + m * 16) * DIN + col0;
                        const f32x4 v0 = acc[ai][bj][m][0] * sc, v1 = acc[ai][bj][m][1] * sc;
                        u32x4 w; w.x = pk2(v0[0], v0[1]); w.y = pk2(v0[2], v0[3]); w.z = pk2(v1[0], v1[1]); w.w = pk2(v1[2], v1[3]);
                        *(GAS u32x4*)rowp = w;
                    }
            }
        }
    }
};
struct EpiResid {
    static constexpr bool PERM = false, AFTER_DRAIN = false;
    const float* xin; float* X;
    __device__ __forceinline__ void operator()(const f32x4 (&acc)[2][2][4][2], const Unit& u, int wr, int wc, int fr, int fq) const {
        const int row0 = u.orow + wr * 64 + fr, col0 = u.ocol + wc * 32 + 4 * fq;
#pragma unroll
        for (int ai = 0; ai < 2; ++ai)
#pragma unroll
            for (int m = 0; m < 4; ++m) { const size_t off = (size_t)(row0 + ai * HALF + m * 16) * D + col0;
#pragma unroll
                for (int bj = 0; bj < 2; ++bj)
#pragma unroll
                    for (int n = 0; n < 2; ++n) { const f32x4 b = *(const GAS f32x4*)(xin + off + bj * HALF + n * 16); *(GAS f32x4*)(X + off + bj * HALF + n * 16) = b + acc[ai][bj][m][n]; } }
    }
};
struct EpiAct {
    static constexpr bool PERM = true, AFTER_DRAIN = false;
    bf16_t* A;
    __device__ __forceinline__ void operator()(const f32x4 (&acc)[2][2][4][2], const Unit& u, int wr, int wc, int fr, int fq) const {
        const int row0 = u.orow + wr * 64 + fr, col0 = (u.ocol >> 1) + wc * 32 + 8 * fq;
#pragma unroll
        for (int ai = 0; ai < 2; ++ai)
#pragma unroll
            for (int m = 0; m < 4; ++m) { const int r = row0 + ai * HALF + m * 16;
                float o[8];
#pragma unroll
                for (int n = 0; n < 2; ++n)
#pragma unroll
                    for (int e = 0; e < 4; ++e) { const float g = acc[ai][0][m][n][e], uu = acc[ai][1][m][n][e];
                        o[4 * n + e] = g * __builtin_amdgcn_rcpf(1.0f + __expf(-g)) * uu; }
                u32x4 w; w.x = pk2(o[0], o[1]); w.y = pk2(o[2], o[3]); w.z = pk2(o[4], o[5]); w.w = pk2(o[6], o[7]);
                if (r < u.rlim) *(GAS u32x4*)(A + (size_t)r * DE + col0) = w; }
    }
};
struct EpiY {
    static constexpr bool PERM = true, AFTER_DRAIN = false;
    bf16_t* Y;
    __device__ __forceinline__ void operator()(const f32x4 (&acc)[2][2][4][2], const Unit& u, int wr, int wc, int fr, int fq) const {
        const int row0 = u.orow + wr * 64 + fr, col0 = u.ocol + wc * 32 + 8 * fq;
#pragma unroll
        for (int ai = 0; ai < 2; ++ai)
#pragma unroll
            for (int m = 0; m < 4; ++m) { const int r = row0 + ai * HALF + m * 16;
#pragma unroll
                for (int bj = 0; bj < 2; ++bj) { const f32x4 v0 = acc[ai][bj][m][0], v1 = acc[ai][bj][m][1];
                    u32x4 w; w.x = pk2(v0[0], v0[1]); w.y = pk2(v0[2], v0[3]); w.z = pk2(v1[0], v1[1]); w.w = pk2(v1[2], v1[3]);
                    if (r < u.rlim) *(GAS u32x4*)(Y + (size_t)r * D + col0 + bj * HALF) = w; } }
    }
};
struct GroupedOrder {
    const LAS int* off; const LAS int* tpre; int lnp, brows, G, c; const int* list; LAS int* tokl;
    __device__ __forceinline__ bool next(int i, Unit& u) const {
        const int total = __builtin_amdgcn_readfirstlane(tpre[NE]) << lnp;
        const long L = (long)i * G + c; if (L >= total) return false;
        const int l = (int)L, pn = l & ((1 << lnp) - 1), tau = l >> lnp;
        int e = 0;
        for (int k = 1; k < NE; ++k) e += (__builtin_amdgcn_readfirstlane(tpre[k]) <= tau) ? 1 : 0;
        const int m = tau - __builtin_amdgcn_readfirstlane(tpre[e]);
        const int o0 = __builtin_amdgcn_readfirstlane(off[e]), o1 = __builtin_amdgcn_readfirstlane(off[e + 1]);
        u.orow = o0 + BM * m; u.rlim = o1;
        if (list) { u.arow = e * T_ROWS + BM * m; u.aend = e * T_ROWS + (o1 - o0); } else { u.arow = u.orow; u.aend = 0; }
        u.brow = e * brows + BM * pn; u.ocol = BM * pn; return true;
    }
    __device__ __forceinline__ void a_ready(const Unit& u, int slot) const {
        if (list) {
            const int tid = threadIdx.x;
            if (tid < 256) { const int idx = u.arow + tid; int tokv = 0;
                if (idx < u.aend) tokv = (int)__hip_atomic_load((const unsigned*)list + idx, __ATOMIC_RELAXED, __HIP_MEMORY_SCOPE_AGENT);
                tokl[slot * 256 + tid] = tokv; }
            asm volatile("s_waitcnt vmcnt(0) lgkmcnt(0)" ::: "memory"); __builtin_amdgcn_s_barrier(); asm volatile("" ::: "memory");
        }
    }
    __device__ __forceinline__ void done(const Unit&) const {}
};
}

struct Args { const float* in[17]; float* out; unsigned char* ws; };
enum { I_X = 0, I_N1G, I_WIN, I_NATB, I_SINK, I_POOLW, I_POOLS, I_WOUT, I_N2G, I_RGW, I_RGB, I_REW, I_REB, I_EG, I_EU, I_ED, I_FG };

struct TrItem { const float* W; bf16_t* WT; int ldw, ldt; };
__device__ __forceinline__ void tr_load(const TrItem& t, f32x4 (&ra)[8], f32x4 (&rb)[8], int lane) {
    const GAS float* Wg = (const GAS float*)t.W;
    const int c4 = lane & 15, rq = lane >> 4;
#pragma unroll
    for (int i = 0; i < 8; ++i) { const int k = 8 * i + 2 * rq; ra[i] = *(const GAS f32x4*)(Wg + (size_t)k * t.ldw + 4 * c4); rb[i] = *(const GAS f32x4*)(Wg + (size_t)(k + 1) * t.ldw + 4 * c4); }
}
__device__ __forceinline__ void tr_store(const TrItem& t, const f32x4 (&ra)[8], const f32x4 (&rb)[8], LAS unsigned* scr, int lane) {
    const int c4 = lane & 15, rq = lane >> 4;
#pragma unroll
    for (int i = 0; i < 8; ++i)
#pragma unroll
        for (int e = 0; e < 4; ++e) scr[(4 * c4 + e) * 32 + 4 * (i ^ (c4 & 7)) + rq] = pk2(ra[i][e], rb[i][e]);
    LDS_WAIT(); asm volatile("" ::: "memory");
    const int kc = lane & 7;
#pragma unroll
    for (int j = 0; j < 8; ++j) { const int n = (lane >> 3) + 8 * j;
        const u32x4 o = *(const LAS u32x4*)(scr + n * 32 + 4 * (kc ^ ((n >> 2) & 7)));
        *(GAS u32x4*)(t.WT + (size_t)n * t.ldt + 8 * kc) = o; }
    LDS_WAIT(); asm volatile("" ::: "memory");
}
__device__ __forceinline__ void norm_row_bf16(const float* xrow, const float* g, bf16_t* orow, int lane) {
    const GAS f32x4* xr = (const GAS f32x4*)xrow + lane; const GAS f32x4* gr = (const GAS f32x4*)g + lane;
    f32x4 v[4]; float s = 0.f;
#pragma unroll
    for (int j = 0; j < 4; ++j) { v[j] = xr[64 * j]; s += (v[j].x * v[j].x + v[j].y * v[j].y) + (v[j].z * v[j].z + v[j].w * v[j].w); }
    const float rstd = 1.0f / sqrtf(wave_sum(s) * (1.0f / D) + RMS_EPS);
    GAS u32x2* o8 = (GAS u32x2*)orow + lane;
#pragma unroll
    for (int j = 0; j < 4; ++j) { const f32x4 gg = gr[64 * j]; u32x2 w; w.x = pk2(v[j].x * rstd * gg.x, v[j].y * rstd * gg.y); w.y = pk2(v[j].z * rstd * gg.z, v[j].w * rstd * gg.w); o8[64 * j] = w; }
}

__device__ __forceinline__ void p0_prologue(LAS unsigned char* lds, int gw, int NGW, int wave, int lane) {
    unsigned char* ws = WSP();
    LAS unsigned* scr = (LAS unsigned*)(lds + wave * 16384);
    constexpr int I0 = 16 * 28, I1 = 16 * 16, I2 = NE * 64, I3 = NE * 64, I4 = NE * 64, I5 = 4, IL = I0 + I1 + I2 + I3 + I4 + I5;
#define TR_DECODE(it_, t_) do { const int l_ = (it_) / IL; int r_ = (it_) - l_ * IL; unsigned char* wl_ = ws + WS_W + (size_t)l_ * W_LAYER; \
        if (r_ < I0) { const int kb = r_ / 28, nb = r_ % 28; t_.W = ARGF(I_WIN) + (size_t)l_ * D * DIN + (size_t)(64 * kb) * DIN + 64 * nb; t_.ldw = DIN; t_.WT = (bf16_t*)(wl_ + W_IN) + (size_t)(64 * nb) * D + 64 * kb; t_.ldt = D; } \
        else if ((r_ -= I0) < I1) { const int kb = r_ >> 4, nb = r_ & 15; t_.W = ARGF(I_WOUT) + (size_t)l_ * D * D + (size_t)(64 * kb) * D + 64 * nb; t_.ldw = D; t_.WT = (bf16_t*)(wl_ + W_OUT) + (size_t)(64 * nb) * D + 64 * kb; t_.ldt = D; } \
        else if ((r_ -= I1) < I2 + I3) { const int up = r_ >= I2; if (up) r_ -= I2; const int e = r_ >> 6, q = r_ & 63, kb = q >> 2, nb = q & 3, n0 = 64 * nb; \
            t_.W = ARGF(up ? I_EU : I_EG) + (size_t)(l_ * NE + e) * D * DE + (size_t)(64 * kb) * DE + n0; t_.ldw = DE; \
            t_.WT = (bf16_t*)(wl_ + W_GU) + (size_t)(e * 512 + 256 * (n0 >> 7) + (n0 & 127) + (up ? 128 : 0)) * D + 64 * kb; t_.ldt = D; } \
        else if ((r_ -= I2 + I3) < I4) { const int e = r_ >> 6, q = r_ & 63, kb = q >> 4, nb = q & 15; \
            t_.W = ARGF(I_ED) + (size_t)(l_ * NE + e) * DE * D + (size_t)(64 * kb) * D + 64 * nb; t_.ldw = D; t_.WT = (bf16_t*)(wl_ + W_DN) + (size_t)e * D * DE + (size_t)(64 * nb) * DE + 64 * kb; t_.ldt = DE; } \
        else { r_ -= I4; t_.W = ARGF(I_POOLW) + (size_t)(l_ * 4 + r_) * 64 * 64; t_.ldw = 64; t_.WT = (bf16_t*)(ws + WS_PW) + (size_t)(l_ * 4 + r_) * 64 * 64; t_.ldt = 64; } } while (0)
    for (int it = gw; it < DEPTH * IL; it += 2 * NGW) {
        const int it2 = it + NGW; const bool two = it2 < DEPTH * IL;
        TrItem ta, tb; TR_DECODE(it, ta); if (two) TR_DECODE(it2, tb); else tb = ta;
        f32x4 a0[8], a1[8], b0[8], b1[8];
        tr_load(ta, a0, a1, lane); tr_load(tb, b0, b1, lane);
        tr_store(ta, a0, a1, scr, lane);
        if (two) tr_store(tb, b0, b1, scr + 2048, lane);
    }
#undef TR_DECODE
}
__device__ __forceinline__ void p0_tables(LAS unsigned char* lds, int gw, int NGW, int wave, int lane) {
    unsigned char* ws = WSP();
    for (int idx = gw * 64 + lane; idx < DEPTH * 48 * 1024; idx += NGW * 64) {
        const int l = idx / (48 * 1024), rem = idx - l * 48 * 1024, rho = rem >> 10, k = rem & 1023;
        float w;
        if (rho < 16) w = ARGF(I_RGW)[((size_t)l * D + k) * 4 + (rho & 3)];
        else { const int q = (rho - 16) & 15, e = 8 * (q >> 2) + (q & 3) + (rho >= 32 ? 4 : 0); w = ARGF(I_REW)[((size_t)l * D + k) * NE + e]; }
        w *= ARGF(I_N2G)[l * D + k];
        const unsigned h = pk2(w, 0.f) & 0xffffu; const float lo = w - bflo(h);
        const int nb = rho >> 4, ii = rho & 15, s = k >> 5, gg = (k >> 3) & 3, ee = k & 7;
        const size_t fo = (size_t)l * 48 * 1024 + ((size_t)((nb * 32 + s) * 64 + gg * 16 + ii)) * 8 + ee;
        ((bf16_t*)(ws + WS_WRH))[fo] = (bf16_t)h; ((bf16_t*)(ws + WS_WRL))[fo] = (bf16_t)(pk2(lo, 0.f) & 0xffffu);
    }
}
__device__ __forceinline__ void p0_norm(LAS unsigned char* lds, int gw, int NGW, int wave, int lane) {
    unsigned char* ws = WSP();
    for (int m = gw; m < T; m += NGW) norm_row_bf16(ARGF(I_X) + (size_t)m * D, ARGF(I_N1G), (bf16_t*)(ws + WS_H) + (size_t)m * D, lane);
}

__device__ __forceinline__ int ksw(int r, int c) { return r * 128 + ((c ^ ((((r >> 3) & 3) << 1) | ((r >> 1) & 1))) << 4); }
__device__ __forceinline__ int vsw(int d, int c) { return d * 1024 + ((c ^ (d & 15)) << 4); }

__device__ __forceinline__ void na_stage(int unit, const bf16_t* proj, const bf16_t* VTa, LAS unsigned char* lds, int tid) {
    const int r = unit & 127, h = (unit >> 7) & 3, b = unit >> 9;
    const int rs = min(max(r - 4, 0), 120);
    const size_t tb0 = (size_t)b * SEQ + rs * 64;
    u32x4 kv[8], vv[8];
#pragma unroll
    for (int it = 0; it < 8; ++it) { const int idx = tid + NTHR * it, rr = idx >> 3, c = idx & 7;
        kv[it] = *(const GAS u32x4*)(proj + (tb0 + rr) * DIN + C_AK + h * 64 + 8 * c); }
#pragma unroll
    for (int it = 0; it < 8; ++it) { const int idx = tid + NTHR * it, d = idx >> 6, c = idx & 63;
        vv[it] = *(const GAS u32x4*)(VTa + ((size_t)((b * 4 + h) * 64 + d)) * SEQ + rs * 64 + 8 * c); }
#pragma unroll
    for (int it = 0; it < 8; ++it) { const int idx = tid + NTHR * it, rr = idx >> 3, c = idx & 7; *(LAS u32x4*)(lds + ksw(rr, c)) = kv[it]; }
#pragma unroll
    for (int it = 0; it < 8; ++it) { const int idx = tid + NTHR * it, d = idx >> 6, c = idx & 63; *(LAS u32x4*)(lds + 65536 + vsw(d, c)) = vv[it]; }
}
__device__ __forceinline__ void na_compute(int unit, int cb, const bf16_t* proj, const float* natb, bf16_t* mix, LAS unsigned char* lds, int lane) {
    const int r = unit & 127, h = (unit >> 7) & 3, b = unit >> 9;
    const int i = lane & 15, g = lane >> 4;
    const int c0 = cb * 16, wsx = (cb == 0) ? 0 : (cb == 1) ? 8 : (cb == 2) ? 24 : 32;
    const int rs = min(max(r - 4, 0), 120);
    const size_t tq = (size_t)b * SEQ + r * 64 + c0 + i;
    const bf16_t* qp = proj + tq * DIN + C_AQ + h * 64 + 8 * g;
    const bf16x8 q0 = *(const GAS bf16x8*)qp, q1 = *(const GAS bf16x8*)(qp + 32);
    const LAS unsigned char* Kt = lds; const LAS unsigned char* Vt = lds + 65536;
    f32x4 sc[8][2];
#pragma unroll
    for (int kb = 0; kb < 2; ++kb) {
        const int row0 = wsx + 8 * (i >> 2) + 4 * kb + (i & 3);
        const int a0 = ksw(row0, g), a1 = ksw(row0, g + 4);
#pragma unroll
        for (int j = 0; j < 8; ++j) {
            const bf16x8 k0 = *(const LAS bf16x8*)(Kt + a0 + j * 8192), k1 = *(const LAS bf16x8*)(Kt + a1 + j * 8192);
            f32x4 acc = {0.f, 0.f, 0.f, 0.f};
            acc = mfma16(k0, q0, acc); acc = mfma16(k1, q1, acc);
            sc[j][kb] = acc;
        }
    }
    const int c = c0 + i, cs = min(max(c - 8, 0), 48);
    const GAS float* nb = (const GAS float*)(natb + h * 15 * 31);
    float mx = -1e30f;
#pragma unroll
    for (int j = 0; j < 8; ++j) {
        const int dr = rs + j - r + 7;
#pragma unroll
        for (int kb = 0; kb < 2; ++kb)
#pragma unroll
            for (int e = 0; e < 4; ++e) {
                const int kc = wsx + 8 * g + 4 * kb + e; const bool valid = (kc >= cs) && (kc < cs + 16);
                const int dc = min(max(kc - c + 15, 0), 30);
                const float bias = nb[dr * 31 + dc];
                const float s = valid ? sc[j][kb][e] + bias : -1e30f;
                sc[j][kb][e] = s; mx = fmaxf(mx, s);
            }
    }
    mx = fmaxf(mx, __shfl_xor(mx, 16)); mx = fmaxf(mx, __shfl_xor(mx, 32));
    float sum = 0.f;
#pragma unroll
    for (int j = 0; j < 8; ++j)
#pragma unroll
        for (int kb = 0; kb < 2; ++kb)
#pragma unroll
            for (int e = 0; e < 4; ++e) { const float p = __expf(sc[j][kb][e] - mx); sc[j][kb][e] = p; sum += p; }
    sum += __shfl_xor(sum, 16); sum += __shfl_xor(sum, 32);
    f32x4 o[4];
#pragma unroll
    for (int db = 0; db < 4; ++db) o[db] = (f32x4){0.f, 0.f, 0.f, 0.f};
#pragma unroll
    for (int j = 0; j < 8; ++j) {
        u32x4 pw; pw.x = pk2(sc[j][0][0], sc[j][0][1]); pw.y = pk2(sc[j][0][2], sc[j][0][3]); pw.z = pk2(sc[j][1][0], sc[j][1][1]); pw.w = pk2(sc[j][1][2], sc[j][1][3]);
        const bf16x8 pb = __builtin_bit_cast(bf16x8, pw);
        const int cc = 8 * j + (wsx >> 3) + g;
#pragma unroll
        for (int db = 0; db < 4; ++db) { const bf16x8 v = *(const LAS bf16x8*)(Vt + vsw(db * 16 + i, cc)); o[db] = mfma16(v, pb, o[db]); }
    }
    const float inv = 1.0f / sum;
    bf16_t* op = mix + tq * D + h * 64 + 4 * g;
#pragma unroll
    for (int db = 0; db < 4; ++db) { u32x2 w; w.x = pk2(o[db][0] * inv, o[db][1] * inv); w.y = pk2(o[db][2] * inv, o[db][3] * inv); *(GAS u32x2*)(op + db * 16) = w; }
}

__device__ __forceinline__ void swa_unit(int unit, const bf16_t* proj, const bf16_t* VTb, const float* sinkp, bf16_t* mix, LAS unsigned char* lds, int tid) {
    const int qblk = unit & 63, kvh = (unit >> 6) & 1, b = unit >> 7;
    const int q0 = qblk * 128, ks0 = q0 - 128;
    LAS unsigned char* Kt = lds; LAS unsigned char* Vt = lds + 51200;
    {
        u32x4 kv[7], vv[7];
#pragma unroll
        for (int it = 0; it < 7; ++it) { const int idx = tid + NTHR * it, rr = idx >> 3, c = idx & 7; const int key = min(max(ks0 + rr, 0), SEQ - 1);
            if (idx < 3200) kv[it] = *(const GAS u32x4*)(proj + ((size_t)b * SEQ + key) * DIN + C_BK + kvh * 64 + 8 * c); }
#pragma unroll
        for (int it = 0; it < 7; ++it) { const int idx = tid + NTHR * it, d = idx / 50, c = idx - d * 50; const int key = min(max(ks0 + 8 * c, 0), SEQ - 8);
            if (idx < 3200) vv[it] = *(const GAS u32x4*)(VTb + ((size_t)((b * 2 + kvh) * 64 + d)) * SEQ + key); }
#pragma unroll
        for (int it = 0; it < 7; ++it) { const int idx = tid + NTHR * it, rr = idx >> 3, c = idx & 7; if (idx < 3200) *(LAS u32x4*)(Kt + ksw(rr, c)) = kv[it]; }
#pragma unroll
        for (int it = 0; it < 7; ++it) { const int idx = tid + NTHR * it, d = idx / 50, c = idx - d * 50; if (idx < 3200) *(LAS u32x4*)(Vt + vsw(d, c)) = vv[it]; }
    }
    __syncthreads();
    const int lane = tid & 63, w = __builtin_amdgcn_readfirstlane(tid >> 6);
    const int i = lane & 15, g = lane >> 4;
    const int tqi = q0 + 16 * w + i;
    const size_t tq = (size_t)b * SEQ + tqi;
#pragma unroll 1
    for (int hh = 0; hh < 4; ++hh) {
        asm volatile("" ::: "memory");
        const int hq = kvh * 4 + hh, w16 = launder_i(16 * w);
        const bf16_t* qp = proj + tq * DIN + C_BQ + hq * 64 + 8 * g;
        const bf16x8 qf0 = *(const GAS bf16x8*)qp, qf1 = *(const GAS bf16x8*)(qp + 32);
        const float slope = exp2f(-(float)(hq + 1));
        f32x4 sc[9][2];
#pragma unroll
        for (int kb = 0; kb < 2; ++kb) {
            const int row0 = 16 * w + 8 * (i >> 2) + 4 * kb + (i & 3);
            const int a0 = ksw(row0, g), a1 = ksw(row0, g + 4);
#pragma unroll
            for (int j = 0; j < 9; ++j) {
                const bf16x8 k0 = *(const LAS bf16x8*)(Kt + a0 + j * 4096), k1 = *(const LAS bf16x8*)(Kt + a1 + j * 4096);
                f32x4 acc = {0.f, 0.f, 0.f, 0.f};
                acc = mfma16(k0, qf0, acc); acc = mfma16(k1, qf1, acc);
                sc[j][kb] = acc;
            }
        }
        const float sink = ((const GAS float*)sinkp)[hq];
        float mx = sink;
#pragma unroll
        for (int j = 0; j < 9; ++j)
#pragma unroll
            for (int kb = 0; kb < 2; ++kb)
#pragma unroll
                for (int e = 0; e < 4; ++e) {
                    const int key = ks0 + w16 + 32 * j + 8 * g + 4 * kb + e; const int df = key - tqi, ad = df < 0 ? -df : df;
                    const bool valid = (key >= 0) && (key < SEQ) && (ad <= 128);
                    const float s = valid ? sc[j][kb][e] - slope * (float)ad : -1e30f;
                    sc[j][kb][e] = s; mx = fmaxf(mx, s);
                }
        mx = fmaxf(mx, __shfl_xor(mx, 16)); mx = fmaxf(mx, __shfl_xor(mx, 32));
        float sum = 0.f;
#pragma unroll
        for (int j = 0; j < 9; ++j)
#pragma unroll
            for (int kb = 0; kb < 2; ++kb)
#pragma unroll
                for (int e = 0; e < 4; ++e) { const float p = __expf(sc[j][kb][e] - mx); sc[j][kb][e] = p; sum += p; }
        sum += __shfl_xor(sum, 16); sum += __shfl_xor(sum, 32);
        sum += __expf(sink - mx);
        f32x4 o[4];
#pragma unroll
        for (int db = 0; db < 4; ++db) o[db] = (f32x4){0.f, 0.f, 0.f, 0.f};
#pragma unroll
        for (int j = 0; j < 9; ++j) {
            u32x4 pw; pw.x = pk2(sc[j][0][0], sc[j][0][1]); pw.y = pk2(sc[j][0][2], sc[j][0][3]); pw.z = pk2(sc[j][1][0], sc[j][1][1]); pw.w = pk2(sc[j][1][2], sc[j][1][3]);
            const bf16x8 pb = __builtin_bit_cast(bf16x8, pw);
            const int cc = 2 * w + 4 * j + g;
#pragma unroll
            for (int db = 0; db < 4; ++db) { const bf16x8 v = *(const LAS bf16x8*)(Vt + vsw(db * 16 + i, cc)); o[db] = mfma16(v, pb, o[db]); }
        }
        const float inv = 1.0f / sum;
        bf16_t* op = mix + tq * D + 256 + hq * 64 + 4 * g;
#pragma unroll
        for (int db = 0; db < 4; ++db) { u32x2 wv; wv.x = pk2(o[db][0] * inv, o[db][1] * inv); wv.y = pk2(o[db][2] * inv, o[db][3] * inv); *(GAS u32x2*)(op + db * 16) = wv; }
    }
    __syncthreads();
}

template <int W>
__device__ __forceinline__ void pool_task_w(int gi, int tb, const bf16_t* proj, const bf16_t* PWt, const float* pscale, bf16_t* mix, int lane) {
    const int i = lane & 15, g = lane >> 4;
    const int t = tb * 16 + i, tin = t & (SEQ - 1), tbase = t - tin;
    constexpr int half = W / 2;
    const int lo = max(tin - half, 0), hi = min(tin + half, SEQ);
    const float rc = 1.0f / (float)(hi - lo);
    bf16x8 dB[2];
#pragma unroll
    for (int ks = 0; ks < 2; ++ks) {
        const bf16_t* cp = proj + C_CU + gi * 64 + ks * 32 + 8 * g;
        u32x4 v[W];
#pragma unroll
        for (int k = 0; k < W; ++k) { const int rr = tin - half + k; const int rrc = min(max(rr, 0), SEQ - 1); v[k] = *(const GAS u32x4*)(cp + (size_t)(tbase + rrc) * DIN); }
        const u32x4 me = *(const GAS u32x4*)(cp + (size_t)t * DIN);
        float s[8];
#pragma unroll
        for (int e = 0; e < 8; ++e) s[e] = 0.f;
#pragma unroll
        for (int k = 0; k < W; ++k) { const int rr = tin - half + k; const float m = ((rr >= 0) && (rr < SEQ)) ? 1.f : 0.f;
            s[0] += m * bflo(v[k].x); s[1] += m * bfhi(v[k].x); s[2] += m * bflo(v[k].y); s[3] += m * bfhi(v[k].y);
            s[4] += m * bflo(v[k].z); s[5] += m * bfhi(v[k].z); s[6] += m * bflo(v[k].w); s[7] += m * bfhi(v[k].w); }
        u32x4 dw;
        dw.x = pk2(s[0] * rc - bflo(me.x), s[1] * rc - bfhi(me.x)); dw.y = pk2(s[2] * rc - bflo(me.y), s[3] * rc - bfhi(me.y));
        dw.z = pk2(s[4] * rc - bflo(me.z), s[5] * rc - bfhi(me.z)); dw.w = pk2(s[6] * rc - bflo(me.w), s[7] * rc - bfhi(me.w));
        dB[ks] = __builtin_bit_cast(bf16x8, dw);
    }
    const bf16_t* pw = PWt + (size_t)gi * 64 * 64 + i * 64 + 8 * g;
    bf16_t* op = mix + (size_t)t * D + 768 + gi * 64 + 4 * g;
    const float* ps = pscale + gi * 64 + 4 * g;
#pragma unroll
    for (int nb = 0; nb < 4; ++nb) {
        const bf16x8 a0 = *(const GAS bf16x8*)(pw + nb * 16 * 64), a1 = *(const GAS bf16x8*)(pw + nb * 16 * 64 + 32);
        f32x4 acc = {0.f, 0.f, 0.f, 0.f};
        acc = mfma16(a0, dB[0], acc); acc = mfma16(a1, dB[1], acc);
        const f32x4 sv = *(const GAS f32x4*)(ps + nb * 16);
        u32x2 wv; wv.x = pk2(acc[0] * sv[0], acc[1] * sv[1]); wv.y = pk2(acc[2] * sv[2], acc[3] * sv[3]);
        *(GAS u32x2*)(op + nb * 16) = wv;
    }
}
__device__ __forceinline__ void pool_task(int task, const bf16_t* proj, const bf16_t* PWt, const float* pscale, bf16_t* mix, int lane) {
    const int gi = task & 3, tb = task >> 2;
    lane = launder_v(lane);
    if (gi == 0) pool_task_w<2>(0, tb, proj, PWt, pscale, mix, lane);
    else if (gi == 1) pool_task_w<4>(1, tb, proj, PWt, pscale, mix, lane);
    else if (gi == 2) pool_task_w<8>(2, tb, proj, PWt, pscale, mix, lane);
    else pool_task_w<16>(3, tb, proj, PWt, pscale, mix, lane);
}

__device__ __forceinline__ void router_task(int t0, const float* X, const bf16_t* WrH, const bf16_t* WrL, const float* rgb, const float* reb,
                                            LAS int* lcnt, LAS int* le, LAS int* lr, int slot0, float* tokg, int lane, int kh, LAS float* part, int rot) {
    const int i = lane & 15, g = lane >> 4;
    const float* xp = X + (size_t)(t0 + i) * D + 8 * g;
    const bf16_t* wh = WrH + (size_t)lane * 8; const bf16_t* wl = WrL + (size_t)lane * 8;
    f32x4 acc[3];
#pragma unroll
    for (int nb = 0; nb < 3; ++nb) acc[nb] = (f32x4){0.f, 0.f, 0.f, 0.f};
    float ss = 0.f;
#pragma unroll 1
    for (int bi = 0; bi < 4; ++bi) {
        const int sb = 16 * kh + 4 * ((bi + rot) & 3);
        f32x4 xa[4], xb[4]; bf16x8 ah[4][3], al[4][3];
#pragma unroll
        for (int u = 0; u < 4; ++u) { xa[u] = *(const GAS f32x4*)(xp + 32 * (sb + u)); xb[u] = *(const GAS f32x4*)(xp + 32 * (sb + u) + 4); }
#pragma unroll
        for (int u = 0; u < 4; ++u)
#pragma unroll
            for (int nb = 0; nb < 3; ++nb) { ah[u][nb] = *(const GAS bf16x8*)(wh + (size_t)((nb * 32 + sb + u) * 64) * 8); al[u][nb] = *(const GAS bf16x8*)(wl + (size_t)((nb * 32 + sb + u) * 64) * 8); }
        __builtin_amdgcn_sched_barrier(0);
#pragma unroll
        for (int u = 0; u < 4; ++u) {
            const f32x4 a = xa[u], b = xb[u];
            ss += (a[0] * a[0] + a[1] * a[1]) + (a[2] * a[2] + a[3] * a[3]) + (b[0] * b[0] + b[1] * b[1]) + (b[2] * b[2] + b[3] * b[3]);
            u32x4 hw; hw.x = pk2(a[0], a[1]); hw.y = pk2(a[2], a[3]); hw.z = pk2(b[0], b[1]); hw.w = pk2(b[2], b[3]);
            u32x4 lw; lw.x = pk2(a[0] - bflo(hw.x), a[1] - bfhi(hw.x)); lw.y = pk2(a[2] - bflo(hw.y), a[3] - bfhi(hw.y));
            lw.z = pk2(b[0] - bflo(hw.z), b[1] - bfhi(hw.z)); lw.w = pk2(b[2] - bflo(hw.w), b[3] - bfhi(hw.w));
            const bf16x8 xh = __builtin_bit_cast(bf16x8, hw), xl = __builtin_bit_cast(bf16x8, lw);
#pragma unroll
            for (int nb = 0; nb < 3; ++nb) { acc[nb] = mfma16(ah[u][nb], xh, acc[nb]); acc[nb] = mfma16(ah[u][nb], xl, acc[nb]); acc[nb] = mfma16(al[u][nb], xh, acc[nb]); }
        }
        __builtin_amdgcn_sched_barrier(0);
    }
    if (kh == 1) {
#pragma unroll
        for (int nb = 0; nb < 3; ++nb)
#pragma unroll
            for (int e = 0; e < 4; ++e) part[(nb * 4 + e) * 64 + lane] = acc[nb][e];
        part[12 * 64 + lane] = ss;
    }
    __syncthreads();
    if (kh == 1) return;
#pragma unroll
    for (int nb = 0; nb < 3; ++nb)
#pragma unroll
        for (int e = 0; e < 4; ++e) acc[nb][e] += part[(nb * 4 + e) * 64 + lane];
    ss += part[12 * 64 + lane];
    ss += __shfl_xor(ss, 16); ss += __shfl_xor(ss, 32);
    const float rstd = 1.0f / sqrtf(ss * (1.0f / D) + RMS_EPS);
    float gl[4]; float gm = -1e30f;
#pragma unroll
    for (int k = 0; k < 4; ++k) { gl[k] = acc[0][k] * rstd + rgb[k]; gm = fmaxf(gm, gl[k]); }
    int gt = 0; float gs = 0.f;
#pragma unroll
    for (int k = 3; k >= 0; --k) { if (gl[k] == gm) gt = k; gs += expf(gl[k] - gm); }
    const float gtp = 1.0f / gs;
    if (g == gt) {
        float el[8]; float em = -1e30f;
#pragma unroll
        for (int k = 0; k < 8; ++k) { el[k] = ((k < 4) ? acc[1][k & 3] : acc[2][k & 3]) * rstd + reb[8 * g + k]; em = fmaxf(em, el[k]); }
        int i0 = 0;
#pragma unroll
        for (int k = 7; k >= 0; --k) if (el[k] == em) i0 = k;
        float e2 = -1e30f;
#pragma unroll
        for (int k = 0; k < 8; ++k) if (k != i0) e2 = fmaxf(e2, el[k]);
        int i1 = 0;
#pragma unroll
        for (int k = 7; k >= 0; --k) if (k != i0 && el[k] == e2) i1 = k;
        const float p1 = expf(e2 - em);
        const float g0 = gtp / (1.0f + p1), g1 = gtp * p1 / (1.0f + p1);
        const int ea = 8 * g + i0, eb = 8 * g + i1;
        const int ra = __hip_atomic_fetch_add((int*)(lcnt + ea), 1, __ATOMIC_RELAXED, __HIP_MEMORY_SCOPE_WORKGROUP);
        const int rb = __hip_atomic_fetch_add((int*)(lcnt + eb), 1, __ATOMIC_RELAXED, __HIP_MEMORY_SCOPE_WORKGROUP);
        le[2 * (slot0 + i)] = ea; le[2 * (slot0 + i) + 1] = eb; lr[2 * (slot0 + i)] = ra; lr[2 * (slot0 + i) + 1] = rb;
        tokg[2 * (size_t)(t0 + i)] = g0; tokg[2 * (size_t)(t0 + i) + 1] = g1;
    }
}

__global__ void __launch_bounds__(NTHR, 2) hybrid_fwd(Args args) {
    extern __shared__ __attribute__((aligned(16))) unsigned char lds_raw[];
    LAS unsigned char* lds = (LAS unsigned char*)lds_raw;
    const int tid = threadIdx.x, lane = tid & 63, wave = __builtin_amdgcn_readfirstlane(tid >> 6);
    const int G = gridDim.x, bx = blockIdx.x;
    const int vcu = (G % 8 == 0) ? (bx % 8) * (G / 8) + bx / 8 : bx;
    const int gw = vcu * NWAVES + wave, NGW = G * NWAVES;
    for (int u = tid; u < (LDS_BYTES - LDSCTL_OFF) / 4; u += NTHR) ((LAS unsigned*)(lds + LDSCTL_OFF))[u] = 0u;
    __syncthreads();
    if (tid == 0) {
        LAS unsigned long long* ap = (LAS unsigned long long*)(lds + ARGS_OFF);
#pragma unroll
        for (int k = 0; k < 17; ++k) ap[k] = (unsigned long long)args.in[k];
        ap[17] = (unsigned long long)args.out; ap[18] = (unsigned long long)args.ws;
    }
    __syncthreads();
    volatile LAS unsigned* MISC = (volatile LAS unsigned*)(lds + MISC_OFF);
    XcdBarrier bar = xcd_barrier_post((unsigned*)(WSP() + WS_CTL) + CW_BAR, MISC + 8);
#ifdef PROBE_ID
    if (threadIdx.x == 0) { volatile LAS unsigned long long* pp = (volatile LAS unsigned long long*)(lds + LDSCTL_OFF + 3072); pp[0] = __builtin_amdgcn_s_memrealtime(); pp[1] = 0; }
#define PROBE_MARK(k) do { if (threadIdx.x == 0) { volatile LAS unsigned long long* pp = (volatile LAS unsigned long long*)(lds + LDSCTL_OFF + 3072); const unsigned long long _n = __builtin_amdgcn_s_memrealtime(); if ((k) == PROBE_ID) pp[1] += _n - pp[0]; pp[0] = _n; } } while (0)
#else
#define PROBE_MARK(k) do { } while (0)
#endif
#define GRID_BAR(k) do { xcd_barrier(bar); PROBE_MARK(k); } while (0)
    LAS int* s_off = (LAS int*)(lds + SCHED_OFF); LAS int* s_tpre = s_off + 40;

    p0_prologue(lds, gw, NGW, wave, launder_v(lane));
    PROBE_MARK(10);
    p0_tables(lds, gw, NGW, wave, launder_v(lane));
    PROBE_MARK(11);
    p0_norm(lds, gw, NGW, wave, launder_v(lane));
    GRID_BAR(0);
#ifdef PROBE_ID
    if (PROBE_ID == 12) { GRID_BAR(99); GRID_BAR(12); GRID_BAR(12); GRID_BAR(12); GRID_BAR(12); }
#endif

#pragma unroll 1
    for (int l = 0; l < DEPTH; ++l) {
        {
            unsigned char* ws = WSP();
            pg8::Gemm g{(const bf16_t*)(ws + WS_H), (const bf16_t*)(ws + WS_W + (size_t)l * W_LAYER + W_IN), launder_i(D)}; pg8::StaticOrder S; S.init(T, DIN, G, bx);
            pg8::EpiProj E{(bf16_t*)(ws + WS_PROJ), (bf16_t*)(ws + WS_VTA), (bf16_t*)(ws + WS_VTB)};
            pg8::gemm_phase<pg8::EpiProj, pg8::StaticOrder, true, true>(lds, g, S, E);
        }
        GRID_BAR(1);
        {
            const int tid = launder_v((int)threadIdx.x), lane = tid & 63;
            unsigned char* ws = WSP();
            const bf16_t* PROJ = (const bf16_t*)(ws + WS_PROJ); bf16_t* MIX = (bf16_t*)(ws + WS_MIX);
            { const bf16_t* VTB = (const bf16_t*)(ws + WS_VTB); const float* sk = ARGF(I_SINK) + l * 8;
              for (int unit = vcu; unit < 256; unit += G) swa_unit(unit, PROJ, VTB, sk, MIX, lds, tid); }
            PROBE_MARK(9);
            { const bf16_t* VTA = (const bf16_t*)(ws + WS_VTA); const float* nb = ARGF(I_NATB) + (size_t)l * 4 * 15 * 31;
              const bf16_t* PW = (const bf16_t*)(ws + WS_PW) + (size_t)l * 4 * 64 * 64; const float* ps = ARGF(I_POOLS) + l * 256;
              const int upc = (1024 + G - 1) / G; const int wv = __builtin_amdgcn_readfirstlane(tid >> 6);
              for (int it = 0; it < upc; ++it) { const int unit = vcu * upc + it;
                  if (unit < 1024) na_stage(unit, PROJ, VTA, lds, tid);
                  __syncthreads();
                  if (unit < 1024) { if (wv < 4) na_compute(unit, wv, PROJ, nb, MIX, lds, lane); else pool_task(unit * 4 + (wv - 4), PROJ, PW, ps, MIX, lane); }
                  __syncthreads(); } }
        }
        GRID_BAR(2);
        {
            unsigned char* ws = WSP(); float* X = (float*)arg_u64(lds, 17);
            pg8::Gemm g{(const bf16_t*)(ws + WS_MIX), (const bf16_t*)(ws + WS_W + (size_t)l * W_LAYER + W_OUT), launder_i(D)}; pg8::StaticOrder S; S.init(T, D, G, bx);
            pg8::EpiResid E{l == 0 ? ARGF(I_X) : (const float*)X, X};
            pg8::gemm_phase<pg8::EpiResid, pg8::StaticOrder, true, true>(lds, g, S, E);
        }
        GRID_BAR(3);
        {
            const int tid = launder_v((int)threadIdx.x), lane = tid & 63;
            unsigned char* ws = WSP(); const float* X = (const float*)arg_u64(lds, 17);
            LAS int* lcnt = (LAS int*)lds; LAS int* lbase = lcnt + 32; LAS int* le = lcnt + 64; LAS int* lr = le + 128;
            gu32* gcnt = (gu32*)(ws + WS_CTL) + CW_CNT + l * 4096;
            int* TOKE = (int*)(ws + WS_TOKE); float* TOKG = (float*)(ws + WS_TOKG); int* TOKR = (int*)(ws + WS_TOKR); int* LIST = (int*)(ws + WS_LIST);
            const float* g2 = ARGF(I_N2G) + l * D; bf16_t* H2 = (bf16_t*)(ws + WS_H);
            for (int bt = vcu; bt < T / 64; bt += G) {
                if (tid < 32) lcnt[tid] = 0;
                __syncthreads();
                { const int wv = __builtin_amdgcn_readfirstlane(tid >> 6), tg = wv & 3;
                  router_task(bt * 64 + tg * 16, X, (const bf16_t*)(ws + WS_WRH) + (size_t)l * 48 * D, (const bf16_t*)(ws + WS_WRL) + (size_t)l * 48 * D,
                              ARGF(I_RGB) + l * 4, ARGF(I_REB) + l * NE, lcnt, le, lr, tg * 16, TOKG, lane, wv >> 2, (LAS float*)(lds + 4096) + tg * 13 * 64, tg + vcu); }
                PROBE_MARK(13);
                __syncthreads();
                if (tid < 32) lbase[tid] = (int)__hip_atomic_fetch_add(gcnt + 64 * tid, (unsigned)lcnt[tid], RLX_AGENT);
                __syncthreads();
                if (tid < 128) { const int e = le[tid], rk = lbase[e] + lr[tid]; TOKE[(size_t)bt * 128 + tid] = e; TOKR[(size_t)bt * 128 + tid] = rk; LIST[(size_t)e * T + rk] = bt * 64 + (tid >> 1); }
                { const int wv = __builtin_amdgcn_readfirstlane(tid >> 6);
                  for (int r = 0; r < 8; ++r) { const int t = bt * 64 + wv * 8 + r; norm_row_bf16(X + (size_t)t * D, g2, H2 + (size_t)t * D, lane); } }
                __syncthreads();
            }
        }
        GRID_BAR(4);
        {
            unsigned char* ws = WSP();
            { gu32* gcnt = (gu32*)(ws + WS_CTL) + CW_CNT + l * 4096;
              if (threadIdx.x == 0) { int o = 0, tp = 0;
#pragma unroll 1
                  for (int e = 0; e < NE; ++e) { const int c = (int)__hip_atomic_load(gcnt + 64 * e, RLX_AGENT); s_off[e] = o; s_tpre[e] = tp; o += c; tp += (c + 255) >> 8; }
                  s_off[NE] = o; s_tpre[NE] = tp; }
              __syncthreads(); }
            pg8::Gemm g{(const bf16_t*)(ws + WS_H), (const bf16_t*)(ws + WS_W + (size_t)l * W_LAYER + W_GU), launder_i(D)};
            pg8::GroupedOrder S{s_off, s_tpre, 1, 512, G, vcu, (const int*)(ws + WS_LIST), (LAS int*)(lds + TOKL_OFF)};
            pg8::EpiAct E{(bf16_t*)(ws + WS_ACT)};
            pg8::gemm_phase<pg8::EpiAct, pg8::GroupedOrder, true, true, true>(lds, g, S, E);
        }
        GRID_BAR(6);
        {
            unsigned char* ws = WSP();
            pg8::Gemm g{(const bf16_t*)(ws + WS_ACT), (const bf16_t*)(ws + WS_W + (size_t)l * W_LAYER + W_DN), launder_i(DE)};
            pg8::GroupedOrder S{s_off, s_tpre, 2, 1024, G, vcu, nullptr, nullptr};
            pg8::EpiY E{(bf16_t*)(ws + WS_HS)};
            pg8::gemm_phase<pg8::EpiY, pg8::GroupedOrder, true, true>(lds, g, S, E);
        }
        GRID_BAR(7);
        {
            const int tid = launder_v((int)threadIdx.x), lane = tid & 63;
            unsigned char* ws = WSP(); float* X = (float*)arg_u64(lds, 17);
            const float* gn = (l + 1 < DEPTH) ? ARGF(I_N1G) + (l + 1) * D : ARGF(I_FG);
            gu32* TOKR = (gu32*)(ws + WS_TOKR); gu32* TOKG = (gu32*)(ws + WS_TOKG); gu32* TOKE = (gu32*)(ws + WS_TOKE); const bf16_t* HS = (const bf16_t*)(ws + WS_HS); bf16_t* H = (bf16_t*)(ws + WS_H);
            for (int t = gw; t < T; t += NGW) {
                const int p0 = s_off[(int)__hip_atomic_load(TOKE + 2 * t, RLX_AGENT)] + (int)__hip_atomic_load(TOKR + 2 * t, RLX_AGENT), p1 = s_off[(int)__hip_atomic_load(TOKE + 2 * t + 1, RLX_AGENT)] + (int)__hip_atomic_load(TOKR + 2 * t + 1, RLX_AGENT);
                const float g0 = __uint_as_float(__hip_atomic_load(TOKG + 2 * t, RLX_AGENT)), g1 = __uint_as_float(__hip_atomic_load(TOKG + 2 * t + 1, RLX_AGENT));
                const GAS f32x4* xr = (const GAS f32x4*)(X + (size_t)t * D) + lane;
                const GAS u32x2* y0 = (const GAS u32x2*)(HS + (size_t)p0 * D) + lane; const GAS u32x2* y1 = (const GAS u32x2*)(HS + (size_t)p1 * D) + lane;
                f32x4 v[4]; float s = 0.f;
#pragma unroll
                for (int j = 0; j < 4; ++j) { const f32x4 x = xr[64 * j]; const u32x2 a = y0[64 * j], b = y1[64 * j];
                    v[j].x = x.x + g0 * bflo(a.x) + g1 * bflo(b.x); v[j].y = x.y + g0 * bfhi(a.x) + g1 * bfhi(b.x);
                    v[j].z = x.z + g0 * bflo(a.y) + g1 * bflo(b.y); v[j].w = x.w + g0 * bfhi(a.y) + g1 * bfhi(b.y);
                    s += (v[j].x * v[j].x + v[j].y * v[j].y) + (v[j].z * v[j].z + v[j].w * v[j].w); }
                const float rstd = 1.0f / sqrtf(wave_sum(s) * (1.0f / D) + RMS_EPS);
                const GAS f32x4* gr = (const GAS f32x4*)gn + lane;
                GAS f32x4* xo = (GAS f32x4*)(X + (size_t)t * D) + lane;
                if (l + 1 < DEPTH) {
                    GAS u32x2* ho = (GAS u32x2*)(H + (size_t)t * D) + lane;
#pragma unroll
                    for (int j = 0; j < 4; ++j) { const f32x4 gg = gr[64 * j]; xo[64 * j] = v[j];
                        u32x2 w; w.x = pk2(v[j].x * rstd * gg.x, v[j].y * rstd * gg.y); w.y = pk2(v[j].z * rstd * gg.z, v[j].w * rstd * gg.w); ho[64 * j] = w; }
                } else {
#pragma unroll
                    for (int j = 0; j < 4; ++j) { const f32x4 gg = gr[64 * j]; xo[64 * j] = (f32x4){v[j].x * rstd * gg.x, v[j].y * rstd * gg.y, v[j].z * rstd * gg.z, v[j].w * rstd * gg.w}; }
                }
            }
        }
        if (l + 1 < DEPTH) GRID_BAR(8); else PROBE_MARK(8);
    }
#ifdef PROBE_ID
    if (blockIdx.x == 0 && threadIdx.x == 0) { const unsigned long long pr_acc = ((volatile LAS unsigned long long*)(lds + LDSCTL_OFF + 3072))[1]; const unsigned long long t0 = __builtin_amdgcn_s_memrealtime(); while (__builtin_amdgcn_s_memrealtime() - t0 < PROBE_MULT * pr_acc) __builtin_amdgcn_s_sleep(8); }
#endif
}

extern "C" void kernel_launch(void* const* d_in, const int* in_sizes, int n_in, void* d_out, int out_size, void* d_ws, size_t ws_size, hipStream_t stream) {
    static int grid = 0;
    if (grid == 0) {
        if (n_in != 17 || out_size != T * D || ws_size < WS_END) { fprintf(stderr, "kernel_launch: unexpected shapes (n_in %d out %d ws %zu)\n", n_in, out_size, ws_size); grid = -1; return; }
        int dev = 0, cus = 0, per_cu = 0;
        if (hipGetDevice(&dev) != hipSuccess || hipDeviceGetAttribute(&cus, hipDeviceAttributeMultiprocessorCount, dev) != hipSuccess) { grid = -1; return; }
        if (hipFuncSetAttribute((const void*)hybrid_fwd, hipFuncAttributeMaxDynamicSharedMemorySize, LDS_BYTES) != hipSuccess) { fprintf(stderr, "kernel_launch: hipFuncSetAttribute failed\n"); grid = -1; return; }
        if (hipOccupancyMaxActiveBlocksPerMultiprocessor(&per_cu, (const void*)hybrid_fwd, NTHR, LDS_BYTES) != hipSuccess || per_cu < 1) { fprintf(stderr, "kernel_launch: occupancy query says %d\n", per_cu); (void)hipGetLastError(); grid = -1; return; }
        grid = cus;
    }
    if (grid < 0) return;
    if (hipMemsetAsync((char*)d_ws + WS_CTL, 0, CTL_ZERO_BYTES, stream) != hipSuccess) { fprintf(stderr, "kernel_launch: memset failed\n"); return; }
    Args a{};
    for (int i = 0; i < 17; ++i) a.in[i] = (const float*)d_in[i];
    a.out = (float*)d_out; a.ws = (unsigned char*)d_ws;
    void* kargs[] = {&a};
    const hipError_t e = hipLaunchCooperativeKernel((const void*)hybrid_fwd, dim3(grid), dim3(NTHR), kargs, LDS_BYTES, stream);
    if (e != hipSuccess) fprintf(stderr, "kernel_launch: cooperative launch failed: %s (grid %d)\n", hipGetErrorString(e), grid);
}
```
